# Optimizing an MI355X kernel written in HIP

```python
import math
import jax
import jax.numpy as jnp
from jax import lax
import numpy as np

D_MODEL = 1024
BATCH = 8
SEQ = 2048
DEPTH = 2

HEAD_DIM = 64
MIX_WIDTH = D_MODEL
GROUP_WIDTH = MIX_WIDTH // 2
EPS = 1e-6
NEG = -1e30
ROPE_THETA = 10000.0

HY_CHANNELS = GROUP_WIDTH
HY_ORDER = 2
HY_IN = (HY_ORDER + 1) * HY_CHANNELS
HY_SHORT = 3
HY_EMB = 33
HY_BANDS = (HY_EMB - 1) // 2
HY_FILTER_HIDDEN = 64
HY_FAST_DECAY = 0.3
HY_SLOW_DECAY = 1.5
HY_DECAY_TARGET = 1e-2
HY_MAX_DECAY = math.log(HY_DECAY_TARGET) / HY_FAST_DECAY
HY_MIN_DECAY = math.log(HY_DECAY_TARGET) / HY_SLOW_DECAY
HY_MOD_SHIFT = 0.05

RET_HEADS = GROUP_WIDTH // HEAD_DIM
RET_CHUNK = 128
EVEN_IN = HY_IN + 4 * GROUP_WIDTH

GRID_W = 64
NA_HEADS = GROUP_WIDTH // HEAD_DIM
NA_ROWS = 8
NA_COLS = 16

DIL_HEADS = GROUP_WIDTH // HEAD_DIM
DIL_BRANCHES = ((128, 1), (512, 4), (2048, 16))
ODD_IN = 3 * NA_HEADS * HEAD_DIM + 3 * DIL_HEADS * HEAD_DIM

PEER_HEADS = 8
PEER_KEYS = 128
PEER_EXPERTS = PEER_KEYS * PEER_KEYS
PEER_DK = 128
PEER_TOPK = 16
PEER_BLOCK = 128

N_EVEN = (DEPTH + 1) // 2
N_ODD = DEPTH // 2

kernel_name = 'hybrid_hyena_retnet_natten_dilated_peer'

F32 = jnp.float32


def _rms_norm(x, gain):
    xf = x.astype(F32)
    y = xf * lax.rsqrt(jnp.mean(xf * xf, axis=-1, keepdims=True) + EPS)
    return (y * gain.astype(F32)).astype(x.dtype)


def _head_rms(t, gain):
    t = t.astype(F32)
    return t * lax.rsqrt(jnp.mean(t * t, axis=-1, keepdims=True) + EPS) * gain.astype(F32)


def _rope(t):
    S, hd = t.shape[1], t.shape[-1]
    inv = ROPE_THETA ** (-jnp.arange(0, hd, 2, dtype=F32) / hd)
    ang = jnp.arange(S, dtype=F32)[:, None] * inv[None, :]
    cos = jnp.cos(ang)[None, :, None, :]
    sin = jnp.sin(ang)[None, :, None, :]
    t1, t2 = jnp.split(t.astype(F32), 2, axis=-1)
    return jnp.concatenate([t1 * cos - t2 * sin, t2 * cos + t1 * sin], axis=-1)


def _hyena_filters(L, fw1, fb1, fw2, fb2, fw3, fb3, fw_out, freq):
    t_norm = jnp.linspace(0.0, 1.0, L, dtype=F32)[:, None]
    w = 2.0 * math.pi * jnp.arange(L, dtype=F32)[:, None] / L
    f = jnp.linspace(1e-4, HY_BANDS - 1, HY_BANDS, dtype=F32)[None, :]
    emb = jnp.concatenate([t_norm, jnp.cos(f * w), -jnp.sin(f * w)], axis=-1)
    fr = freq.astype(F32)
    hdn = jnp.sin(fr * (emb @ fw1.astype(F32) + fb1.astype(F32)))
    hdn = jnp.sin(fr * (hdn @ fw2.astype(F32) + fb2.astype(F32)))
    hdn = jnp.sin(fr * (hdn @ fw3.astype(F32) + fb3.astype(F32)))
    filt = (hdn @ fw_out.astype(F32)).reshape(L, HY_ORDER, 2, HY_CHANNELS)
    deltas = jnp.abs(jnp.linspace(HY_MIN_DECAY, HY_MAX_DECAY, HY_CHANNELS, dtype=F32))
    window = jnp.exp(-t_norm * deltas[None, :]) + HY_MOD_SHIFT
    filt = filt * window[:, None, None, :]
    fwd = filt[:, :, 0]
    bwd = filt[:, :, 1]
    circ = jnp.concatenate([fwd, jnp.zeros_like(fwd[:1]), bwd[:0:-1]], axis=0)
    return jnp.fft.rfft(circ, axis=0)


def _fft_long_conv(z, filt_f, skip):
    L = z.shape[1]
    zf = jnp.fft.rfft(z, n=2 * L, axis=1)
    y = jnp.fft.irfft(zf * filt_f[None], n=2 * L, axis=1)[:, :L]
    return y + z * skip.astype(F32)


def _hyena(u, conv_w, conv_b, fw1, fb1, fw2, fb2, fw3, fb3, fw_out, freq, skip):
    L = u.shape[1]
    up = jnp.pad(u, ((0, 0), (1, 1), (0, 0)))
    cw = conv_w.astype(F32)
    uc = up[:, :-2] * cw[0] + up[:, 1:-1] * cw[1] + up[:, 2:] * cw[2] + conv_b.astype(F32)
    v, x1, x2 = jnp.split(uc, 3, axis=-1)
    filt_f = _hyena_filters(L, fw1, fb1, fw2, fb2, fw3, fb3, fw_out, freq)
    z = x1 * _fft_long_conv(v, filt_f[:, 0], skip[0])
    return x2 * _fft_long_conv(z, filt_f[:, 1], skip[1])


def _retention_scan(q, k, v, log_g, strict):
    B, H, S, dk = q.shape
    dv = v.shape[-1]
    C = RET_CHUNK
    n = S // C
    qc = q.reshape(B, H, n, C, dk)
    kc = k.reshape(B, H, n, C, dk)
    vc = v.reshape(B, H, n, C, dv)
    pos = jnp.arange(C, dtype=F32)
    lg = log_g[:, None]
    diff = pos[:, None] - pos[None, :]
    keep = (diff > 0) if strict else (diff >= 0)
    dmat = jnp.where(keep[None], jnp.exp(lg[:, :, None] * jnp.maximum(diff, 0.0)[None]), 0.0)
    scores = jnp.einsum('bhncd,bhnkd->bhnck', qc, kc) * dmat[None, :, None]
    y_intra = jnp.einsum('bhnck,bhnke->bhnce', scores, vc)
    k_dec = jnp.exp(lg * (C - 1 - pos))
    q_dec = jnp.exp(lg * (pos + 1))
    kv = jnp.einsum('bhncd,bhnce->nbhde', kc * k_dec[None, :, None, :, None], vc)
    chunk_decay = jnp.exp(lg[:, 0] * C)[None, :, None, None]

    def step(state, kv_i):
        return state * chunk_decay + kv_i, state

    _, prev = lax.scan(step, jnp.zeros((B, H, dk, dv), F32), kv)
    y_cross = jnp.einsum('bhncd,nbhde->bhnce', qc * q_dec[None, :, None, :, None], prev)
    return (y_intra + y_cross).reshape(B, H, S, dv)


def _retention(r_in, log_decay_param, gn_gain):
    B, S, _ = r_in.shape
    rq, rk, rv, rg = jnp.split(r_in, 4, axis=-1)
    shp = (B, S, RET_HEADS, HEAD_DIM)
    q = _rope(rq.reshape(shp)).transpose(0, 2, 1, 3)
    k = (_rope(rk.reshape(shp)) * HEAD_DIM ** -0.5).transpose(0, 2, 1, 3)
    v = rv.reshape(shp).transpose(0, 2, 1, 3)
    log_g = -jnp.exp(log_decay_param.astype(F32))
    y_fwd = _retention_scan(q, k, v, log_g[0], False)
    rev = lambda t: t[:, :, ::-1]
    y_bwd = rev(_retention_scan(rev(q), rev(k), rev(v), log_g[1], True))
    y = (y_fwd + y_bwd).transpose(0, 2, 1, 3)
    y = y * lax.rsqrt(jnp.mean(y * y, axis=-1, keepdims=True) + EPS)
    y = y.reshape(B, S, GROUP_WIDTH) * gn_gain.astype(F32)
    return jax.nn.silu(rg) * y


def _neighbourhood_attention(q, k, v, rpb):
    B, S, H, hd = q.shape
    rows = S // GRID_W
    kh = min(NA_ROWS, rows)
    r = jnp.arange(rows)
    row_idx = jnp.clip(r - kh // 2, 0, rows - kh)[:, None] + jnp.arange(kh)[None, :]
    c = jnp.arange(GRID_W)
    c0 = jnp.clip(c - NA_COLS // 2, 0, GRID_W - NA_COLS)
    col_valid = (c[None, :] >= c0[:, None]) & (c[None, :] < c0[:, None] + NA_COLS)
    col_off = jnp.clip(c[None, :] - c[:, None] + NA_COLS - 1, 0, 2 * NA_COLS - 2)
    row_off = row_idx - r[:, None] + NA_ROWS - 1
    qg = q.reshape(B, rows, GRID_W, H, hd)
    kb = k.reshape(B, rows, GRID_W, H, hd)[:, row_idx]
    vb = v.reshape(B, rows, GRID_W, H, hd)[:, row_idx]
    s = jnp.einsum('brqhd,brkchd->bhrqkc', qg, kb)
    bias = rpb.astype(F32)[:, row_off[:, None, :, None], col_off[None, :, None, :]]
    s = jnp.where(col_valid[:, None, :], s + bias[None], NEG)
    p = jax.nn.softmax(s, axis=(-2, -1))
    o = jnp.einsum('bhrqkc,brkchd->brqhd', p, vb)
    return o.reshape(B, S, H, hd)


def _band_attention(q, k, v, radius):
    N, L, hd = q.shape
    blk = radius
    nb = -(-L // blk)
    pad = nb * blk - L
    qb = jnp.pad(q, ((0, 0), (0, pad), (0, 0))).reshape(N, nb, blk, hd)
    kp = jnp.pad(k, ((0, 0), (blk, blk + pad), (0, 0))).reshape(N, nb + 2, blk, hd)
    vp = jnp.pad(v, ((0, 0), (blk, blk + pad), (0, 0))).reshape(N, nb + 2, blk, hd)
    kb = jnp.concatenate([kp[:, :-2], kp[:, 1:-1], kp[:, 2:]], axis=2)
    vb = jnp.concatenate([vp[:, :-2], vp[:, 1:-1], vp[:, 2:]], axis=2)
    qi = (jnp.arange(nb)[:, None] * blk + jnp.arange(blk)[None, :])[:, :, None]
    kj = (jnp.arange(nb)[:, None] * blk - blk + jnp.arange(3 * blk)[None, :])[:, None, :]
    valid = (jnp.abs(kj - qi) <= radius) & (kj >= 0) & (kj < L)
    s = jnp.where(valid[None], jnp.einsum('nbqd,nbkd->nbqk', qb, kb), NEG)
    m = jnp.max(s, axis=-1, keepdims=True)
    p = jnp.exp(s - m)
    den = jnp.sum(p, axis=-1, keepdims=True)
    o = jnp.einsum('nbqk,nbkd->nbqd', p, vb) / den
    lse = (m + jnp.log(den))[..., 0]
    return o.reshape(N, nb * blk, hd)[:, :L], lse.reshape(N, nb * blk)[:, :L]


def _dilated_attention(q, k, v):
    B, S, H, hd = q.shape
    outs, lses = [], []
    for window, dil in DIL_BRANCHES:
        Ls = S // dil

        def to_sub(t, Ls=Ls, dil=dil):
            return t.reshape(B, Ls, dil, H, hd).transpose(0, 2, 3, 1, 4).reshape(B * dil * H, Ls, hd)

        o, lse = _band_attention(to_sub(q), to_sub(k), to_sub(v), window // (2 * dil))
        outs.append(o.reshape(B, dil, H, Ls, hd).transpose(0, 3, 1, 2, 4).reshape(B, S, H, hd))
        lses.append(lse.reshape(B, dil, H, Ls).transpose(0, 3, 1, 2).reshape(B, S, H))
    wts = jax.nn.softmax(jnp.stack(lses), axis=0)
    return jnp.sum(wts[..., None] * jnp.stack(outs), axis=0)


def _peer(xn, w_q, sub_keys, u, v):
    B, S, D = xn.shape
    T = B * S
    xt = xn.reshape(T, D)
    q = (xt @ w_q).astype(F32).reshape(T, PEER_HEADS, 2, PEER_DK // 2)
    sc = jnp.einsum('thpd,hpkd->thpk', q, sub_keys.astype(F32))
    s_top, i_top = lax.top_k(sc, PEER_TOPK)
    cand_s = (s_top[:, :, 0, :, None] + s_top[:, :, 1, None, :]).reshape(T, PEER_HEADS, PEER_TOPK * PEER_TOPK)
    cand_i = (i_top[:, :, 0, :, None] * PEER_KEYS + i_top[:, :, 1, None, :]).reshape(T, PEER_HEADS, PEER_TOPK * PEER_TOPK)
    g_s, pick = lax.top_k(cand_s, PEER_TOPK)
    experts = jnp.take_along_axis(cand_i, pick, axis=-1).reshape(T, PEER_HEADS * PEER_TOPK)
    gates = jax.nn.softmax(g_s, axis=-1).reshape(T, PEER_HEADS * PEER_TOPK)
    nblk = T // PEER_BLOCK

    def block(args):
        xb, eb, gb = args
        ub = jnp.take(u, eb, axis=0)
        act = jax.nn.gelu(jnp.einsum('td,tkd->tk', xb, ub).astype(F32)) * gb
        vb = jnp.take(v, eb, axis=0)
        return jnp.einsum('tk,tkd->td', act, vb.astype(F32))

    out = lax.map(block, (xt.reshape(nblk, PEER_BLOCK, D),
                          experts.reshape(nblk, PEER_BLOCK, -1),
                          gates.reshape(nblk, PEER_BLOCK, -1)))
    return out.reshape(B, S, D)


def setup_inputs(seed: int = 0) -> dict:
    key = jax.random.key(seed)
    ks = iter(jax.random.split(key, 32))

    def nrm(shape, std):
        return std * jax.random.normal(next(ks), shape, F32)

    Hf = HY_FILTER_HIDDEN
    ret_init = jnp.log(-jnp.log1p(-jnp.power(2.0, -5.0 - jnp.arange(RET_HEADS, dtype=F32))))
    return {
        'x': nrm((BATCH, SEQ, D_MODEL), 1.0),
        'mix_norm_gain': 1.0 + nrm((DEPTH, D_MODEL), 0.02),
        'ffn_norm_gain': 1.0 + nrm((DEPTH, D_MODEL), 0.02),
        'ev_w_in': nrm((N_EVEN, D_MODEL, EVEN_IN), D_MODEL ** -0.5),
        'ev_w_out': nrm((N_EVEN, MIX_WIDTH, D_MODEL), MIX_WIDTH ** -0.5),
        'hy_conv_w': nrm((N_EVEN, HY_SHORT, HY_IN), HY_SHORT ** -0.5),
        'hy_conv_b': nrm((N_EVEN, HY_IN), 0.02),
        'hy_fw1': nrm((N_EVEN, HY_EMB, Hf), HY_EMB ** -0.5),
        'hy_fb1': nrm((N_EVEN, Hf), 0.1),
        'hy_fw2': nrm((N_EVEN, Hf, Hf), Hf ** -0.5),
        'hy_fb2': nrm((N_EVEN, Hf), 0.1),
        'hy_fw3': nrm((N_EVEN, Hf, Hf), Hf ** -0.5),
        'hy_fb3': nrm((N_EVEN, Hf), 0.1),
        'hy_fw_out': nrm((N_EVEN, Hf, HY_ORDER * 2 * HY_CHANNELS), 0.01),
        'hy_freq': 1.0 + nrm((N_EVEN, Hf), 0.05),
        'hy_skip': nrm((N_EVEN, HY_ORDER, HY_CHANNELS), 1.0),
        'ret_log_decay': ret_init[None, None, :] + nrm((N_EVEN, 2, RET_HEADS), 0.05),
        'ret_gn_gain': 1.0 + nrm((N_EVEN, GROUP_WIDTH), 0.02),
        'od_w_in': nrm((N_ODD, D_MODEL, ODD_IN), D_MODEL ** -0.5),
        'od_w_out': nrm((N_ODD, MIX_WIDTH, D_MODEL), MIX_WIDTH ** -0.5),
        'na_qk_gain': 1.0 + nrm((N_ODD, 2, HEAD_DIM), 0.02),
        'na_rpb': nrm((N_ODD, NA_HEADS, 2 * NA_ROWS - 1, 2 * NA_COLS - 1), 0.05),
        'dil_qk_gain': 1.0 + nrm((N_ODD, 2, HEAD_DIM), 0.02),
        'peer_w_q': nrm((DEPTH, D_MODEL, PEER_HEADS * PEER_DK), D_MODEL ** -0.5),
        'peer_sub_keys': nrm((DEPTH, PEER_HEADS, 2, PEER_KEYS, PEER_DK // 2), (PEER_DK // 2) ** -0.5),
        'peer_u': nrm((DEPTH, PEER_EXPERTS, D_MODEL), D_MODEL ** -0.5),
        'peer_v': nrm((DEPTH, PEER_EXPERTS, D_MODEL), PEER_HEADS ** -0.5),
    }


def reference(x, mix_norm_gain, ffn_norm_gain, ev_w_in, ev_w_out, hy_conv_w, hy_conv_b,
              hy_fw1, hy_fb1, hy_fw2, hy_fb2, hy_fw3, hy_fb3, hy_fw_out, hy_freq, hy_skip,
              ret_log_decay, ret_gn_gain, od_w_in, od_w_out, na_qk_gain, na_rpb, dil_qk_gain,
              peer_w_q, peer_sub_keys, peer_u, peer_v):
    B, S, _ = x.shape
    scale = HEAD_DIM ** -0.5
    for layer in range(DEPTH):
        h = _rms_norm(x, mix_norm_gain[layer])
        if layer % 2 == 0:
            e = layer // 2
            proj = (h @ ev_w_in[e]).astype(F32)
            a_out = _hyena(proj[..., :HY_IN], hy_conv_w[e], hy_conv_b[e], hy_fw1[e], hy_fb1[e],
                           hy_fw2[e], hy_fb2[e], hy_fw3[e], hy_fb3[e], hy_fw_out[e], hy_freq[e], hy_skip[e])
            b_out = _retention(proj[..., HY_IN:], ret_log_decay[e], ret_gn_gain[e])
            mixed = jnp.concatenate([a_out, b_out], axis=-1).astype(x.dtype) @ ev_w_out[e]
        else:
            o = layer // 2
            proj = (h @ od_w_in[o]).astype(F32)
            na_q, na_k, na_v, dl_q, dl_k, dl_v = jnp.split(proj, 6, axis=-1)
            shp = (B, S, NA_HEADS, HEAD_DIM)
            nq = _head_rms(na_q.reshape(shp), na_qk_gain[o, 0]) * scale
            nk = _head_rms(na_k.reshape(shp), na_qk_gain[o, 1])
            c_out = _neighbourhood_attention(nq, nk, na_v.reshape(shp), na_rpb[o])
            dshp = (B, S, DIL_HEADS, HEAD_DIM)
            dq = _rope(_head_rms(dl_q.reshape(dshp), dil_qk_gain[o, 0])) * scale
            dk = _rope(_head_rms(dl_k.reshape(dshp), dil_qk_gain[o, 1]))
            d_out = _dilated_attention(dq, dk, dl_v.reshape(dshp))
            mixed = jnp.concatenate([c_out.reshape(B, S, -1), d_out.reshape(B, S, -1)],
                                    axis=-1).astype(x.dtype) @ od_w_out[o]
        x = x + mixed.astype(x.dtype)
        x = x + _peer(_rms_norm(x, ffn_norm_gain[layer]), peer_w_q[layer], peer_sub_keys[layer],
                      peer_u[layer], peer_v[layer]).astype(x.dtype)
    return x
```

```cpp
#include <hip/hip_runtime.h>
#include <cstdio>
#include <math.h>
#include <stdint.h>

__device__ __forceinline__ int ltid() { int t = threadIdx.x; asm volatile("" : "+v"(t)); return t; }
namespace pg8 {
#define PG8_LAS __attribute__((address_space(3)))
typedef unsigned short bf16_t;
typedef short bf16x8 __attribute__((ext_vector_type(8)));
typedef float f32x4 __attribute__((ext_vector_type(4)));
typedef unsigned u32x4 __attribute__((ext_vector_type(4)));
constexpr int BM = 256, BK = 64, HALF = 128, HTB = HALF * BK * 2  , STAGE_BYTES = 8 * HTB, NXCD = 8, WGM = 4;

__host__ __device__ __forceinline__ int lds_byte(int r, int c) { const int st = (r >> 4) * 2 + (c >> 5), rr = r & 15, cc = c & 31, ob = rr * 64 + cc * 2; return st * 1024 + (ob ^ (((ob >> 9) & 1) << 5)); }
__host__ __device__ __forceinline__ void stage_rc(int b, int& R, int& C) { const int st = b / 1024, sb = b % 1024, swz = sb ^ (((sb >> 9) & 1) << 5); R = (st >> 1) * 16 + swz / 64; C = (st & 1) * 32 + (swz % 64) / 2; }
__host__ __device__ __forceinline__ int perm32(int rho) { const int n = rho >> 4, i = rho & 15; return 8 * (i >> 2) + 4 * n + (i & 3); }

struct Unit { int pm, pn; };
struct Gemm { const bf16_t* A; const bf16_t* Bt; int M, N, K; };

struct StaticOrder {
    int nM, nN, nwg, G, c;
    __host__ __device__ __forceinline__ void init(int M, int N, int G_, int c_) { nM = M / BM; nN = N / BM; nwg = nM * nN; G = G_; c = c_; }
    __host__ __device__ __forceinline__ bool next(int i, Unit& u) const {
        const long L = (long)i * G + c; if (L >= nwg) return false;
        int wgid = (int)L; { const int q = nwg / NXCD, r = nwg % NXCD, xcd = wgid % NXCD, off = wgid / NXCD; wgid = (xcd < r ? xcd * (q + 1) : r * (q + 1) + (xcd - r) * q) + off; }
        const int nig = WGM * nN, gid = wgid / nig, fm = gid * WGM, gsz = (nM - fm) < WGM ? (nM - fm) : WGM;
        u.pm = fm + ((wgid % nig) % gsz); u.pn = (wgid % nig) / gsz; return true;
    }
    __device__ __forceinline__ void a_ready(const Unit&) const {}
    __device__ __forceinline__ void done(const Unit&) const {}
};

__device__ __forceinline__ unsigned cvt_pk_bf16(float lo, float hi) { unsigned r; asm volatile("v_cvt_pk_bf16_f32 %0, %1, %2" : "=v"(r) : "v"(lo), "v"(hi)); return r; }
typedef float f32x2 __attribute__((ext_vector_type(2)));
__device__ __forceinline__ f32x2 gelu_pk(f32x2 v) {
    const f32x2 av = __builtin_elementwise_abs(v), d = av * 0.2316418882f + 1.0f;
    f32x2 t; t.x = __builtin_amdgcn_rcpf(d.x); t.y = __builtin_amdgcn_rcpf(d.y);
    f32x2 q = t * 0.5307027145f + (-0.7265760135f); q = q * t + 0.7107068705f; q = q * t + (-0.142248368f); q = q * t + 0.127414796f; q = q * t;
    const f32x2 s = (v * v) * (-0.72134752044f);
    f32x2 e; e.x = __builtin_amdgcn_exp2f(s.x); e.y = __builtin_amdgcn_exp2f(s.y);
    const f32x2 m = v * (q * e), r = v - m;
    f32x2 o; o.x = v.x < 0.f ? m.x : r.x; o.y = v.y < 0.f ? m.y : r.y; return o;
}

template <int ACT  > struct EpiBf16 {
    static constexpr bool PERM = true, AFTER_DRAIN = false, HEADMAP = false, F8_RECOMP = false; static_assert(ACT == 0 || ACT == 1, "EpiBf16: ACT is 0 (none) or 1 (gelu_pk)");
    bf16_t* O; int ldc; const float* bias; int split_cols; size_t split_stride; float scale0;
    __device__ __forceinline__ void operator()(const f32x4 (&acc)[2][2][4][2], const Unit& u, int wr, int wc, int fr, int fq) const {
        const int row0 = u.pm * BM + wr * 64 + fr; int colt = u.pn * BM; bf16_t* base = O;
        float sc = 1.f; if (split_cols) { const int t = colt / split_cols; base += (size_t)t * split_stride; colt -= t * split_cols; if (t == 0) sc = scale0; }
        const int col0 = colt + wc * 32 + 8 * fq, bcol0 = u.pn * BM + wc * 32 + 8 * fq;
        f32x4 bv[2][2];
#pragma unroll
        for (int bj = 0; bj < 2; ++bj)
#pragma unroll
            for (int n = 0; n < 2; ++n) bv[bj][n] = bias ? *(const f32x4*)(bias + bcol0 + bj * HALF + 4 * n) : (f32x4){0.f, 0.f, 0.f, 0.f};
#pragma unroll
        for (int ai = 0; ai < 2; ++ai)
#pragma unroll
            for (int m = 0; m < 4; ++m) { bf16_t* rowp = base + (size_t)(row0 + ai * HALF + m * 16) * ldc + col0;
#pragma unroll
                for (int bj = 0; bj < 2; ++bj) { f32x4 v0 = acc[ai][bj][m][0] + bv[bj][0], v1 = acc[ai][bj][m][1] + bv[bj][1];
                    if (ACT == 1) { f32x2 a = gelu_pk((f32x2){v0[0], v0[1]}), b = gelu_pk((f32x2){v0[2], v0[3]}), c = gelu_pk((f32x2){v1[0], v1[1]}), d = gelu_pk((f32x2){v1[2], v1[3]});
                        v0 = (f32x4){a.x, a.y, b.x, b.y}; v1 = (f32x4){c.x, c.y, d.x, d.y}; }
                    v0 = v0 * sc; v1 = v1 * sc; u32x4 w; w.x = cvt_pk_bf16(v0[0], v0[1]); w.y = cvt_pk_bf16(v0[2], v0[3]); w.z = cvt_pk_bf16(v1[0], v1[1]); w.w = cvt_pk_bf16(v1[2], v1[3]);
                    *(u32x4*)(rowp + bj * HALF) = w; } }
    }
};

template <bool RBF>
struct EpiResXB {
    static constexpr bool PERM = false, AFTER_DRAIN = false, HEADMAP = false, F8_RECOMP = true;
    const void* R; int ldc; bf16_t* XB; float* rowss; float oscale  ;
    __device__ __forceinline__ void operator()(const f32x4 (&acc)[2][2][4][2], const Unit& u, int wr, int wc, int fr, int fq) const {
        typedef __bf16 bf2v __attribute__((ext_vector_type(2))); typedef float f2v __attribute__((ext_vector_type(2))); typedef unsigned u2v __attribute__((ext_vector_type(2)));
        const int row0 = u.pm * BM + wr * 64 + fr, col0 = u.pn * BM + wc * 32 + 4 * fq;
#pragma unroll
        for (int ai = 0; ai < 2; ++ai)
#pragma unroll
            for (int m = 0; m < 4; ++m) { const int row = row0 + ai * HALF + m * 16; const size_t off = (size_t)row * ldc + col0; float ss = 0.f;
#pragma unroll
                for (int bj = 0; bj < 2; ++bj)
#pragma unroll
                    for (int n = 0; n < 2; ++n) { f32x4 rv;
                        if (RBF) { const u2v rw = *(const u2v*)((const bf16_t*)R + off + bj * HALF + n * 16);
                            rv[0] = __builtin_bit_cast(float, rw.x << 16); rv[1] = __builtin_bit_cast(float, rw.x & 0xffff0000u); rv[2] = __builtin_bit_cast(float, rw.y << 16); rv[3] = __builtin_bit_cast(float, rw.y & 0xffff0000u); }
                        else rv = *(const f32x4*)((const float*)R + off + bj * HALF + n * 16);
                        const f32x4 v = acc[ai][bj][m][n] * oscale + rv;
                        ss += (v[0] * v[0] + v[1] * v[1]) + (v[2] * v[2] + v[3] * v[3]);
                        f2v lo; lo.x = v[0]; lo.y = v[1]; f2v hi; hi.x = v[2]; hi.y = v[3]; u2v w; w.x = __builtin_bit_cast(unsigned, __builtin_convertvector(lo, bf2v)); w.y = __builtin_bit_cast(unsigned, __builtin_convertvector(hi, bf2v));
                        *(u2v*)(XB + off + bj * HALF + n * 16) = w; }
                ss += __shfl_xor(ss, 16); ss += __shfl_xor(ss, 32);
                if (fq == 0) rowss[(size_t)row * 16 + u.pn * 4 + wc] = ss; }
    }
};
struct EpiBf16Row {
    static constexpr bool PERM = true, AFTER_DRAIN = false, HEADMAP = false, F8_RECOMP = false;
    bf16_t* O; int ldc; const float* rowss; float invk, eps;
    __device__ __forceinline__ void operator()(const f32x4 (&acc)[2][2][4][2], const Unit& u, int wr, int wc, int fr, int fq) const {
        const int row0 = u.pm * BM + wr * 64 + fr; const int col0 = u.pn * BM + wc * 32 + 8 * fq;
#pragma unroll
        for (int ai = 0; ai < 2; ++ai)
#pragma unroll
            for (int m = 0; m < 4; ++m) { const int row = row0 + ai * HALF + m * 16; const f32x4* rp = (const f32x4*)(rowss + (size_t)row * 16); const f32x4 p0 = rp[0], p1 = rp[1], p2 = rp[2], p3 = rp[3];
                const float rs = (((p0[0] + p0[1]) + (p0[2] + p0[3])) + ((p1[0] + p1[1]) + (p1[2] + p1[3]))) + (((p2[0] + p2[1]) + (p2[2] + p2[3])) + ((p3[0] + p3[1]) + (p3[2] + p3[3])));
                const float sc = 1.0f / sqrtf(rs * invk + eps); bf16_t* rowp = O + (size_t)row * ldc + col0;
#pragma unroll
                for (int bj = 0; bj < 2; ++bj) { const f32x4 v0 = acc[ai][bj][m][0] * sc, v1 = acc[ai][bj][m][1] * sc;
                    u32x4 w; w.x = cvt_pk_bf16(v0[0], v0[1]); w.y = cvt_pk_bf16(v0[2], v0[3]); w.z = cvt_pk_bf16(v1[0], v1[1]); w.w = cvt_pk_bf16(v1[2], v1[3]);
                    *(u32x4*)(rowp + bj * HALF) = w; } }
    }
};
template <int MODE> struct EpiHead {
    static constexpr bool PERM = true, AFTER_DRAIN = false, HEADMAP = true, F8_RECOMP = false;
    bf16_t* O; int ldc; const float* na_gain; const float* dil_gain; const float* CS  ; int posmask; float eps; float oscale  ;
    __device__ __forceinline__ void operator()(const f32x4 (&acc)[2][2][4][2], const Unit& u, int wr, int wc, int fr, int fq) const {
        const int which = u.pn >> 1;
        bool do_norm, do_rope; float sc; const float* gain = na_gain;
        if (MODE == 0) { do_norm = false; do_rope = which < 2; sc = (which == 1) ? 0.125f : 1.0f; }
        else { do_norm = (which != 2 && which != 5); do_rope = (which == 3 || which == 4); sc = (which == 0 || which == 3) ? 0.125f : 1.0f;
               gain = (which < 2) ? na_gain + which * 64 : dil_gain + (which == 4 ? 64 : 0); }
        const int row0 = u.pm * BM + wr * 64 + fr, col0 = u.pn * BM + wc * 64 + 8 * fq;
        f32x4 gv[2][2];
#pragma unroll
        for (int bj = 0; bj < 2; ++bj)
#pragma unroll
            for (int n = 0; n < 2; ++n) { gv[bj][n] = (f32x4){sc, sc, sc, sc}; if (MODE == 1 && do_norm) gv[bj][n] = *(const f32x4*)(gain + 32 * bj + 8 * fq + 4 * n) * sc; }
#pragma unroll
        for (int ai = 0; ai < 2; ++ai)
#pragma unroll
            for (int m = 0; m < 4; ++m) { const int row = row0 + ai * HALF + m * 16;
                f32x4 v[2][2];
#pragma unroll
                for (int bj = 0; bj < 2; ++bj)
#pragma unroll
                    for (int n = 0; n < 2; ++n) v[bj][n] = acc[ai][bj][m][n] * oscale;
                float r = 1.0f;
                if (MODE == 1 && do_norm) { float ss = 0.f;
#pragma unroll
                    for (int bj = 0; bj < 2; ++bj)
#pragma unroll
                        for (int n = 0; n < 2; ++n) ss += (v[bj][n][0] * v[bj][n][0] + v[bj][n][1] * v[bj][n][1]) + (v[bj][n][2] * v[bj][n][2] + v[bj][n][3] * v[bj][n][3]);
                    ss += __shfl_xor(ss, 16); ss += __shfl_xor(ss, 32); r = 1.0f / sqrtf(ss * (1.0f / 64.0f) + eps); }
#pragma unroll
                for (int bj = 0; bj < 2; ++bj)
#pragma unroll
                    for (int n = 0; n < 2; ++n) v[bj][n] = v[bj][n] * gv[bj][n] * r;
                if (do_rope) { const f32x4* cp = (const f32x4*)(CS + ((size_t)(row & posmask) * 32 + 8 * fq) * 2);
#pragma unroll
                    for (int n = 0; n < 2; ++n) { const f32x4 c01 = cp[2 * n], c23 = cp[2 * n + 1]; const f32x4 a = v[0][n], b = v[1][n];
                        v[0][n][0] = a[0] * c01[0] - b[0] * c01[1]; v[1][n][0] = b[0] * c01[0] + a[0] * c01[1];
                        v[0][n][1] = a[1] * c01[2] - b[1] * c01[3]; v[1][n][1] = b[1] * c01[2] + a[1] * c01[3];
                        v[0][n][2] = a[2] * c23[0] - b[2] * c23[1]; v[1][n][2] = b[2] * c23[0] + a[2] * c23[1];
                        v[0][n][3] = a[3] * c23[2] - b[3] * c23[3]; v[1][n][3] = b[3] * c23[2] + a[3] * c23[3]; } }
                bf16_t* rowp = O + (size_t)row * ldc + col0;
#pragma unroll
                for (int bj = 0; bj < 2; ++bj) { u32x4 w; w.x = cvt_pk_bf16(v[bj][0][0], v[bj][0][1]); w.y = cvt_pk_bf16(v[bj][0][2], v[bj][0][3]); w.z = cvt_pk_bf16(v[bj][1][0], v[bj][1][1]); w.w = cvt_pk_bf16(v[bj][1][2], v[bj][1][3]);
                    *(u32x4*)(rowp + 32 * bj) = w; } }
    }
};
struct EpiF32R {
    static constexpr bool PERM = false, AFTER_DRAIN = false, HEADMAP = false, F8_RECOMP = false;
    float* C; int ldc; const float* R;
    __device__ __forceinline__ void operator()(const f32x4 (&acc)[2][2][4][2], const Unit& u, int wr, int wc, int fr, int fq) const {
        const int row0 = u.pm * BM + wr * 64 + fr, col0 = u.pn * BM + wc * 32 + 4 * fq;
#pragma unroll
        for (int ai = 0; ai < 2; ++ai)
#pragma unroll
            for (int m = 0; m < 4; ++m) { const size_t off = (size_t)(row0 + ai * HALF + m * 16) * ldc + col0;
#pragma unroll
                for (int bj = 0; bj < 2; ++bj)
#pragma unroll
                    for (int n = 0; n < 2; ++n) { f32x4 v = acc[ai][bj][m][n]; if (R) v = v + *(const f32x4*)(R + off + bj * HALF + n * 16); *(f32x4*)(C + off + bj * HALF + n * 16) = v; } }
    }
};

template <class Epi, class Sched, bool ALIGN_EPI = false, bool SP2 = false, bool F8 = false>
__device__ __forceinline__ void gemm_phase(PG8_LAS unsigned char* lds, const Gemm g, const Sched& S, const Epi& E) {
    const int tid = ltid(), wid = __builtin_amdgcn_readfirstlane(tid >> 6), lane = tid & 63, wr = wid >> 2, wc = wid & 3, fr = lane & 15, fq = lane >> 4;
    const int K = g.K, rowb = F8 ? K : 2 * K, nt = rowb / (BK * 2);
    unsigned voffA[2], voffB[2];
#pragma unroll
    for (int i = 0; i < 2; ++i) { int R, C; stage_rc(tid * 16 + i * 8192, R, C); const int Rb = Epi::HEADMAP ? (64 * (R >> 5) + perm32(R & 31)) : (Epi::PERM ? ((R & ~31) + perm32(R & 31)) : R);
        voffA[i] = (unsigned)(R * rowb + 2 * C); voffB[i] = (unsigned)(Rb * rowb + 2 * C); }
    auto voffA_of = [&](int t_, int i_) -> unsigned { asm volatile("" : "+v"(t_)); int R, C; stage_rc(t_ * 16 + i_ * 8192, R, C); return (unsigned)(R * rowb + 2 * C); };
    auto voffB_of = [&](int t_, int i_) -> unsigned { asm volatile("" : "+v"(t_)); int R, C; stage_rc(t_ * 16 + i_ * 8192, R, C); const int Rb = Epi::HEADMAP ? (64 * (R >> 5) + perm32(R & 31)) : (Epi::PERM ? ((R & ~31) + perm32(R & 31)) : R); return (unsigned)(Rb * rowb + 2 * C); };
    (void)voffA_of; (void)voffB_of;
    const size_t kstep = (size_t)(BK * 2);
    const size_t hstep = (size_t)HALF * rowb;
    const size_t tstep = 2 * hstep;
    const size_t bstep = Epi::HEADMAP ? (size_t)32 * rowb : hstep;
    const unsigned ldsw = (unsigned)wid * 1024u;
    const int aoff = F8 ? lds_byte(wr * 64 + fr, fq * 16) : lds_byte(wr * 64 + fr, fq * 8), boff = F8 ? lds_byte(wc * 32 + fr, fq * 16) : lds_byte(wc * 32 + fr, fq * 8);
    constexpr int akst = F8 ? 16 : 1024, bkst = F8 ? 16 : 1024;
#define PG8_SA(b, h) (((b) * 2 + (h)) * HTB)
#define PG8_SB(b, h) ((4 + (b) * 2 + (h)) * HTB)
#define PG8_STAGE(bufoff, gbase, voff) do { _Pragma("unroll") for (int _i = 0; _i < 2; ++_i) \
        { unsigned vo_ = (voff)[_i]; if constexpr (F8 && Epi::F8_RECOMP) vo_ = voff##_of(tid, _i); else if constexpr (F8) asm volatile("" : "+v"(vo_));        \
        __builtin_amdgcn_global_load_lds((const unsigned*)((const char*)(gbase) + vo_), (PG8_LAS unsigned*)(lds + (bufoff) + ldsw + _i * 8192), 16, 0, 0); } } while (0)
#define PG8_LDA(dst, b, h) do { _Pragma("unroll") for (int m = 0; m < 4; ++m) { if constexpr (F8) { const PG8_LAS unsigned char* p_ = lds + PG8_SA(b, h) + aoff + m * 2048; \
        dst##8[m] = *(const PG8_LAS v8i_*)p_; } \
        else { _Pragma("unroll") for (int k = 0; k < 2; ++k) dst[m][k] = *(const PG8_LAS bf16x8*)(lds + PG8_SA(b, h) + aoff + m * 2048 + k * akst); } } } while (0)
#define PG8_LDB(dst, b, h) do { _Pragma("unroll") for (int n = 0; n < 2; ++n) { if constexpr (F8) { const PG8_LAS unsigned char* p_ = lds + PG8_SB(b, h) + boff + n * 2048; \
        dst##8[n] = *(const PG8_LAS v8i_*)p_; } \
        else { _Pragma("unroll") for (int k = 0; k < 2; ++k) dst[n][k] = *(const PG8_LAS bf16x8*)(lds + PG8_SB(b, h) + boff + n * 2048 + k * bkst); } } } while (0)
#define PG8_MMA(ai, bj, At, Bt) do { __builtin_amdgcn_s_setprio(1); _Pragma("unroll") for (int m = 0; m < 4; ++m) _Pragma("unroll") for (int n = 0; n < 2; ++n) { \
        if constexpr (F8) acc[ai][bj][m][n] = __builtin_amdgcn_mfma_scale_f32_16x16x128_f8f6f4(Bt##8[n], At##8[m], acc[ai][bj][m][n], 0, 0, 0, 0, 0, 0); \
        else { _Pragma("unroll") for (int k = 0; k < 2; ++k) acc[ai][bj][m][n] = __builtin_amdgcn_mfma_f32_16x16x32_bf16(Bt[n][k], At[m][k], acc[ai][bj][m][n], 0, 0, 0); } } \
        __builtin_amdgcn_s_setprio(0); } while (0)
#define PG8_WAIT_V(n) asm volatile("s_waitcnt vmcnt(" #n ")" ::: "memory")
#define PG8_WAIT_L(n) asm volatile("s_waitcnt lgkmcnt(" #n ")" ::: "memory")
#define PG8_BAR __builtin_amdgcn_s_barrier()
#define PG8_SCHED __builtin_amdgcn_sched_barrier(0)
    Unit cur, nxt; int ui = 0;
    if (!S.next(0, cur)) return;
    f32x4 acc[2][2][4][2];
#pragma unroll
    for (int a = 0; a < 2; ++a)
#pragma unroll
        for (int b = 0; b < 2; ++b)
#pragma unroll
            for (int m = 0; m < 4; ++m)
#pragma unroll
                for (int n = 0; n < 2; ++n) acc[a][b][m][n] = (f32x4){0.f, 0.f, 0.f, 0.f};
    bf16x8 At[4][2], B0[2][2], B1[2][2];
    typedef int v4i_ __attribute__((ext_vector_type(4))); typedef int v8i_ __attribute__((ext_vector_type(8)));
    v8i_ At8[4], B08[2], B18[2];
    (void)At; (void)B0; (void)B1; (void)At8; (void)B08; (void)B18;
    const char* cA = (const char*)g.A + (size_t)cur.pm * tstep; const char* cB = (const char*)g.Bt + (size_t)cur.pn * tstep;
    S.a_ready(cur);
    if constexpr (SP2) {
        PG8_STAGE(PG8_SB(0, 0), cB, voffB); PG8_STAGE(PG8_SB(0, 1), cB + bstep, voffB); PG8_STAGE(PG8_SA(0, 0), cA, voffA); PG8_STAGE(PG8_SA(0, 1), cA + hstep, voffA);
        if (wr == 1) PG8_BAR;
        PG8_WAIT_V(2); PG8_BAR;
        PG8_STAGE(PG8_SB(1, 0), cB + kstep, voffB); PG8_STAGE(PG8_SA(1, 0), cA + kstep, voffA); PG8_STAGE(PG8_SB(1, 1), cB + bstep + kstep, voffB);
        PG8_WAIT_V(6); PG8_BAR;
    } else {
        PG8_STAGE(PG8_SB(0, 0), cB, voffB); PG8_STAGE(PG8_SA(0, 0), cA, voffA); PG8_STAGE(PG8_SB(0, 1), cB + bstep, voffB); PG8_STAGE(PG8_SA(0, 1), cA + hstep, voffA);
        if (wr == 1) PG8_BAR;
        PG8_WAIT_V(4); PG8_BAR;
        PG8_STAGE(PG8_SB(1, 0), cB + kstep, voffB); PG8_STAGE(PG8_SA(1, 0), cA + kstep, voffA); PG8_STAGE(PG8_SB(1, 1), cB + bstep + kstep, voffB);
        PG8_WAIT_V(6); PG8_BAR;
    }
    for (;;) {
        const bool has_next = S.next(ui + 1, nxt);
        const char* nA = has_next ? (const char*)g.A + (size_t)nxt.pm * tstep : cA; const char* nB = has_next ? (const char*)g.Bt + (size_t)nxt.pn * tstep : cB;
#pragma unroll 1
        for (int t = 0; t < nt; t += 2) {
            const bool last = (t == nt - 2);
            const char* a1 = cA + (size_t)(t + 1) * kstep;
            const char* a2 = last ? nA : cA + (size_t)(t + 2) * kstep; const char* b2 = last ? nB : cB + (size_t)(t + 2) * kstep;
            const char* a3 = a2 + kstep; const char* b3 = b2 + kstep;
            if (last && has_next) S.a_ready(nxt);
            if constexpr (SP2) {
            PG8_LDB(B0, 0, 0); PG8_LDB(B1, 0, 1); PG8_SCHED; PG8_LDA(At, 0, 0); PG8_STAGE(PG8_SA(1, 1), a1 + hstep, voffA);
            PG8_WAIT_V(8); PG8_WAIT_L(0); PG8_BAR; PG8_MMA(0, 0, At, B0); PG8_MMA(0, 1, At, B1); PG8_BAR; PG8_SCHED;
            PG8_LDA(At, 0, 1); PG8_STAGE(PG8_SB(0, 0), b2, voffB); PG8_STAGE(PG8_SB(0, 1), b2 + bstep, voffB); PG8_STAGE(PG8_SA(0, 0), a2, voffA);
            PG8_WAIT_V(8); PG8_WAIT_L(0); PG8_BAR; PG8_MMA(1, 0, At, B0); PG8_MMA(1, 1, At, B1); PG8_BAR; PG8_SCHED;
            PG8_LDB(B0, 1, 0); PG8_LDB(B1, 1, 1); PG8_SCHED; PG8_LDA(At, 1, 0); PG8_STAGE(PG8_SA(0, 1), a2 + hstep, voffA);
            PG8_WAIT_V(8); PG8_WAIT_L(0); PG8_BAR; PG8_MMA(0, 0, At, B0); PG8_MMA(0, 1, At, B1); PG8_BAR; PG8_SCHED;
            PG8_LDA(At, 1, 1); PG8_STAGE(PG8_SB(1, 0), b3, voffB); PG8_STAGE(PG8_SB(1, 1), b3 + bstep, voffB); PG8_STAGE(PG8_SA(1, 0), a3, voffA);
            PG8_WAIT_V(8); PG8_WAIT_L(0); PG8_BAR; PG8_MMA(1, 0, At, B0); PG8_MMA(1, 1, At, B1); PG8_BAR; PG8_SCHED;
            } else {
            PG8_LDB(B0, 0, 0); PG8_SCHED; PG8_LDA(At, 0, 0); PG8_STAGE(PG8_SA(1, 1), a1 + hstep, voffA);
            PG8_WAIT_L(8); PG8_BAR; PG8_WAIT_L(0); PG8_MMA(0, 0, At, B0); PG8_BAR; PG8_SCHED;
            PG8_LDB(B1, 0, 1); PG8_STAGE(PG8_SB(0, 0), b2, voffB);
            PG8_BAR; PG8_WAIT_L(0); PG8_MMA(0, 1, At, B1); PG8_BAR;
            PG8_LDA(At, 0, 1); PG8_STAGE(PG8_SA(0, 0), a2, voffA);
            PG8_BAR; PG8_WAIT_L(0); PG8_MMA(1, 0, At, B0); PG8_BAR; PG8_SCHED;
            PG8_STAGE(PG8_SB(0, 1), b2 + bstep, voffB);
            PG8_WAIT_V(6); PG8_BAR; PG8_MMA(1, 1, At, B1); PG8_BAR;
            PG8_LDB(B0, 1, 0); PG8_SCHED; PG8_LDA(At, 1, 0); PG8_STAGE(PG8_SA(0, 1), a2 + hstep, voffA);
            PG8_WAIT_L(8); PG8_BAR; PG8_WAIT_L(0); PG8_MMA(0, 0, At, B0); PG8_BAR; PG8_SCHED;
            PG8_LDB(B1, 1, 1); PG8_STAGE(PG8_SB(1, 0), b3, voffB);
            PG8_BAR; PG8_WAIT_L(0); PG8_MMA(0, 1, At, B1); PG8_BAR;
            PG8_LDA(At, 1, 1); PG8_STAGE(PG8_SA(1, 0), a3, voffA);
            PG8_BAR; PG8_WAIT_L(0); PG8_MMA(1, 0, At, B0); PG8_BAR; PG8_SCHED;
            PG8_STAGE(PG8_SB(1, 1), b3 + bstep, voffB);
            PG8_WAIT_V(6); PG8_BAR; PG8_MMA(1, 1, At, B1); PG8_BAR;
            }
        }
        if constexpr (ALIGN_EPI) { if (wr == 0) PG8_BAR; }
        if constexpr (!Epi::AFTER_DRAIN) { const int l2_ = ltid() & 63; E(acc, cur, wr, wc, l2_ & 15, l2_ >> 4); S.done(cur); }
        if (!has_next) break;
#pragma unroll
        for (int a = 0; a < 2; ++a)
#pragma unroll
            for (int b = 0; b < 2; ++b)
#pragma unroll
                for (int m = 0; m < 4; ++m)
#pragma unroll
                    for (int n = 0; n < 2; ++n) acc[a][b][m][n] = (f32x4){0.f, 0.f, 0.f, 0.f};
        cur = nxt; cA = nA; cB = nB; ++ui;
        if constexpr (ALIGN_EPI) { if (wr == 1) PG8_BAR; }
    }
    PG8_WAIT_V(0);
    if constexpr (!ALIGN_EPI) { if (wr == 0) PG8_BAR; }
    PG8_BAR;
    if constexpr (Epi::AFTER_DRAIN) { E.fused(acc, cur, wr, wc, fr, fq, lds, wid, lane); S.done(cur); }
#undef PG8_SA
#undef PG8_SB
#undef PG8_STAGE
#undef PG8_LDA
#undef PG8_LDB
#undef PG8_MMA
#undef PG8_WAIT_V
#undef PG8_WAIT_L
#undef PG8_BAR
#undef PG8_SCHED
}
}

namespace {
constexpr int NB = 8, S = 2048, D = 1024, T = NB * S;
constexpr int EVEN_IN = 3584, ODD_IN = 3072, HY_IN = 1536, HYC = 512;
constexpr float EPS = 1e-6f;
#define LAS __attribute__((address_space(3)))
typedef unsigned short bf16;
typedef unsigned v4u __attribute__((ext_vector_type(4)));
constexpr int LDS_BYTES = 147456;
__device__ __forceinline__ unsigned f2bf(float f) { unsigned u = __builtin_bit_cast(unsigned, f); return (u + 0x7fffu + ((u >> 16) & 1u)) >> 16; }
__device__ __forceinline__ unsigned pk2(float lo, float hi) { return f2bf(lo) | (f2bf(hi) << 16); }
typedef __bf16 bf2_t_ __attribute__((ext_vector_type(2)));
typedef float f32x2_t_ __attribute__((ext_vector_type(2)));
__device__ __forceinline__ unsigned pkbf(float lo, float hi) { f32x2_t_ v; v.x = lo; v.y = hi; return __builtin_bit_cast(unsigned, __builtin_convertvector(v, bf2_t_)); }
__device__ __forceinline__ float bf2f(unsigned short b) { return __builtin_bit_cast(float, (unsigned)b << 16); }
__device__ __forceinline__ float bflo(unsigned w) { return __builtin_bit_cast(float, w << 16); }
__device__ __forceinline__ float bfhi(unsigned w) { return __builtin_bit_cast(float, w & 0xffff0000u); }
__device__ __forceinline__ float4 ld4bf(const unsigned short* p) { const uint2 w = *(const uint2*)p; return make_float4(bflo(w.x), bfhi(w.x), bflo(w.y), bfhi(w.y)); }

constexpr float W8_SCALE = 32.0f;
__device__ __forceinline__ unsigned pk4_fp8(float a, float b, float c, float d) { int w = 0; w = __builtin_amdgcn_cvt_pk_fp8_f32(a, b, w, false); w = __builtin_amdgcn_cvt_pk_fp8_f32(c, d, w, true); return (unsigned)w; }
__device__ __forceinline__ float wave_sum(float v) {
#pragma unroll
    for (int o = 1; o < 64; o <<= 1) v += __shfl_xor(v, o);
    return v;
}

__device__ __forceinline__ void k_rmsnorm(int vb, int tid, const float* x, const float* __restrict__ gain, float* y, unsigned short* yb) {
    const int row = vb * 4 + (tid >> 6), lane = tid & 63;
    const float4* xr = (const float4*)(x + (size_t)row * D);
    const float4* g4 = (const float4*)gain;
    float4 v[4]; float s = 0.f;
#pragma unroll
    for (int j = 0; j < 4; ++j) { v[j] = xr[lane + 64 * j]; s += v[j].x * v[j].x + v[j].y * v[j].y + v[j].z * v[j].z + v[j].w * v[j].w; }
    s = wave_sum(s);
    const float r = 1.0f / sqrtf(s * (1.0f / D) + EPS);
#pragma unroll
    for (int j = 0; j < 4; ++j) { const float4 g = g4[lane + 64 * j]; float4 o; o.x = v[j].x * r * g.x; o.y = v[j].y * r * g.y; o.z = v[j].z * r * g.z; o.w = v[j].w * r * g.w;
        if (y) ((float4*)(y + (size_t)row * D))[lane + 64 * j] = o;
        if (yb) { uint2 w; w.x = pk2(o.x, o.y); w.y = pk2(o.z, o.w); ((uint2*)(yb + (size_t)row * D))[lane + 64 * j] = w; } }
}


typedef short bf16x8 __attribute__((ext_vector_type(8)));
typedef float f32x16 __attribute__((ext_vector_type(16)));
typedef unsigned u32x4 __attribute__((ext_vector_type(4)));
typedef unsigned u32x2 __attribute__((ext_vector_type(2)));
typedef __bf16 bf16x2_t __attribute__((ext_vector_type(2)));
typedef float f32x2_t __attribute__((ext_vector_type(2)));
__device__ __forceinline__ float max3f(float a, float b, float c) { return fmaxf(fmaxf(a, b), c); }
__device__ __forceinline__ int f2sort(float f) { const int b = __float_as_int(f); return b ^ ((b >> 31) & 0x7fffffff); }
__device__ __forceinline__ float sort2f(int k) { return __int_as_float(k ^ ((k >> 31) & 0x7fffffff)); }
__device__ __forceinline__ void ce_desc(int& a, int& b) { const int hi = a > b ? a : b, lo = a > b ? b : a; a = hi; b = lo; }
template <int N> __device__ __forceinline__ void bitonic_sort_desc(int (&a)[N]) {
#pragma unroll
    for (int k = 2; k <= N; k <<= 1)
#pragma unroll
        for (int j = k >> 1; j >= 1; j >>= 1)
#pragma unroll
            for (int i = 0; i < N; ++i) { const int l = i ^ j; if (l > i) { if ((i & k) == 0) ce_desc(a[i], a[l]); else ce_desc(a[l], a[i]); } }
}
__device__ __forceinline__ void top16_merge(int (&a)[16], const int (&b)[16]) {
#pragma unroll
    for (int i = 0; i < 16; ++i) a[i] = a[i] > b[15 - i] ? a[i] : b[15 - i];
#pragma unroll
    for (int j = 8; j >= 1; j >>= 1)
#pragma unroll
        for (int i = 0; i < 16; ++i) { const int l = i ^ j; if (l > i) ce_desc(a[i], a[l]); }
}
template <bool QLDS>
__device__ __forceinline__ void peer_select_unit(const unsigned short* Qb, const unsigned short* SKB, int tt, int h, int lane, LAS float* scr, unsigned short* EXPo, float* GATEo) {
    const int r32 = lane & 31, hh = lane >> 5;
    const int t = tt * 32 + r32;
    bf16x8 qpre[2][4];
    if (QLDS) {
#pragma unroll
        for (int p = 0; p < 2; ++p)
#pragma unroll
            for (int ks = 0; ks < 4; ++ks) qpre[p][ks] = *(const LAS bf16x8*)((const LAS unsigned char*)scr + r32 * 256 + (((p * 8 + ks * 2 + hh) ^ (r32 & 15)) * 16));
    }
#pragma unroll 1
    for (int p = 0; p < 2; ++p) {
        f32x16 acc[4];
#pragma unroll
        for (int kt = 0; kt < 4; ++kt)
#pragma unroll
            for (int i = 0; i < 16; ++i) acc[kt][i] = 0.f;
        bf16x8 qf[4];
#pragma unroll
        for (int ks = 0; ks < 4; ++ks) { if (QLDS) qf[ks] = p ? qpre[1][ks] : qpre[0][ks]; else qf[ks] = *(const bf16x8*)(Qb + (size_t)t * D + h * 128 + p * 64 + ks * 16 + hh * 8); }
#pragma unroll
        for (int kt = 0; kt < 4; ++kt)
#pragma unroll
            for (int ks = 0; ks < 4; ++ks) {
                const bf16x8 kf = *(const bf16x8*)(SKB + ((size_t)((h * 2 + p) * 128 + kt * 32 + r32)) * 64 + ks * 16 + hh * 8);
                acc[kt] = __builtin_amdgcn_mfma_f32_32x32x16_bf16(kf, qf[ks], acc[kt], 0, 0, 0);
            }
        int g[4][16];
#pragma unroll
        for (int kt = 0; kt < 4; ++kt)
#pragma unroll
            for (int i = 0; i < 16; ++i) {
                const unsigned key = (unsigned)(kt * 32 + (i & 3) + 8 * (i >> 2)) + 4u * (unsigned)hh;
                const float av = acc[kt][i];
                g[kt][i] = f2sort(__uint_as_float((__float_as_uint(av) & ~127u) | key));
            }
#pragma unroll
        for (int kt = 0; kt < 4; ++kt) bitonic_sort_desc(g[kt]);
        top16_merge(g[0], g[1]); top16_merge(g[2], g[3]); top16_merge(g[0], g[2]);
        int pb[16];
#pragma unroll
        for (int i = 0; i < 16; ++i) pb[i] = __shfl_xor(g[0][i], 32);
        top16_merge(g[0], pb);
#pragma unroll
        for (int i = 0; i < 16; ++i) scr[(p * 16 + i) * 64 + lane] = sort2f(g[0][i]);
    }
    float ta[16], tb[16];
#pragma unroll
    for (int i = 0; i < 16; ++i) { ta[i] = scr[i * 64 + lane]; tb[i] = scr[(16 + i) * 64 + lane]; }
    int cand[32];
#pragma unroll
    for (int i = 25; i < 32; ++i) cand[i] = (int)0x80000000;
    {
        int c = 0;
#pragma unroll
        for (int a = 0; a < 16; ++a)
#pragma unroll
            for (int bq = 0; bq < 16; ++bq) {
                if ((a + 1) * (bq + 1) <= 16) {
                    const float sum = ta[a] + tb[bq];
                    const int packed = f2sort(__uint_as_float((__float_as_uint(sum) & ~255u) | (unsigned)(a * 16 + bq)));
                    if ((c & 1) == 0) cand[c >> 1] = packed;
                    else cand[c >> 1] = hh ? packed : cand[c >> 1];
                    ++c;
                }
            }
    }
    bitonic_sort_desc(cand);
    int top[16], pb2[16];
#pragma unroll
    for (int i = 0; i < 16; ++i) { top[i] = cand[i]; pb2[i] = __shfl_xor(cand[i], 32); }
    top16_merge(top, pb2);
    if (hh == 0) {
        float gs[16]; unsigned es[16];
#pragma unroll
        for (int i = 0; i < 16; ++i) {
            const float gv = sort2f(top[i]); const unsigned bits = __float_as_uint(gv);
            const unsigned ka = __float_as_uint(scr[((bits >> 4) & 15u) * 64 + lane]) & 127u, kb = __float_as_uint(scr[(16 + (bits & 15u)) * 64 + lane]) & 127u;
            gs[i] = gv; es[i] = ka * 128u + kb;
        }
        float sm = 0.f; const float g0 = gs[0];
#pragma unroll
        for (int i = 0; i < 16; ++i) { gs[i] = __expf(gs[i] - g0); sm += gs[i]; }
        const float inv = 1.0f / sm;
        u32x4* eo = (u32x4*)(EXPo + (size_t)t * 128 + h * 16);
        u32x4 w0, w1;
        w0.x = es[0] | (es[1] << 16); w0.y = es[2] | (es[3] << 16); w0.z = es[4] | (es[5] << 16); w0.w = es[6] | (es[7] << 16);
        w1.x = es[8] | (es[9] << 16); w1.y = es[10] | (es[11] << 16); w1.z = es[12] | (es[13] << 16); w1.w = es[14] | (es[15] << 16);
        eo[0] = w0; eo[1] = w1;
        float4* go = (float4*)(GATEo + (size_t)t * 128 + h * 16);
#pragma unroll
        for (int i = 0; i < 4; ++i) go[i] = make_float4(gs[4 * i] * inv, gs[4 * i + 1] * inv, gs[4 * i + 2] * inv, gs[4 * i + 3] * inv);
    }
}

struct EpiQSel {
    static constexpr bool PERM = true, AFTER_DRAIN = true, HEADMAP = false, F8_RECOMP = true;
    const float* rowss; float invk, eps; const unsigned short* SKB; unsigned short* EXPo; float* GATEo;
    __device__ __forceinline__ void operator()(const pg8::f32x4 (&)[2][2][4][2], const pg8::Unit&, int, int, int, int) const {}
    __device__ __forceinline__ void fused(const pg8::f32x4 (&acc)[2][2][4][2], const pg8::Unit& u, int wr, int wc, int fr, int fq, PG8_LAS unsigned char* lds, int wid, int lane) const {
#pragma unroll
        for (int ai = 0; ai < 2; ++ai)
#pragma unroll
            for (int m = 0; m < 4; ++m) { const int row = ai * 128 + wr * 64 + m * 16 + fr; const pg8::f32x4* rp = (const pg8::f32x4*)(rowss + (size_t)(u.pm * 256 + row) * 16); const pg8::f32x4 p0 = rp[0], p1 = rp[1], p2 = rp[2], p3 = rp[3];
                const float rs = (((p0[0] + p0[1]) + (p0[2] + p0[3])) + ((p1[0] + p1[1]) + (p1[2] + p1[3]))) + (((p2[0] + p2[1]) + (p2[2] + p2[3])) + ((p3[0] + p3[1]) + (p3[2] + p3[3])));
                const float sc = 1.0f / sqrtf(rs * invk + eps); const int rr = row & 31;
#pragma unroll
                for (int bj = 0; bj < 2; ++bj) { const pg8::f32x4 v0 = acc[ai][bj][m][0] * sc, v1 = acc[ai][bj][m][1] * sc;
                    pg8::u32x4 w; w.x = pg8::cvt_pk_bf16(v0[0], v0[1]); w.y = pg8::cvt_pk_bf16(v0[2], v0[3]); w.z = pg8::cvt_pk_bf16(v1[0], v1[1]); w.w = pg8::cvt_pk_bf16(v1[2], v1[3]);
                    *(PG8_LAS pg8::u32x4*)(lds + (bj * 8 + (row >> 5)) * 8192 + rr * 256 + (((4 * wc + fq) ^ (rr & 15)) * 16)) = w; } }
        __syncthreads();
#pragma unroll 1
        for (int hs = 0; hs < 2; ++hs) peer_select_unit<true>(nullptr, SKB, u.pm * 8 + wid, 2 * u.pn + hs, lane, (LAS float*)(lds + (hs * 8 + wid) * 8192), EXPo, GATEo);
        __syncthreads();
    }
};
struct OneUnit {
    pg8::Unit u0;
    __device__ __forceinline__ bool next(int k, pg8::Unit& u) const { if (k != 0) return false; u = u0; return true; }
    __device__ __forceinline__ void a_ready(const pg8::Unit&) const {}
    __device__ __forceinline__ void done(const pg8::Unit&) const {}
};

constexpr float U8_SCALE = 45.0f, V8_SCALE = 4.0f;
__device__ __forceinline__ float dot2bf(unsigned a, bf16x2_t b, float c) { return __builtin_amdgcn_fdot2_f32_bf16(__builtin_bit_cast(bf16x2_t, a), b, c, false); }
__device__ __forceinline__ unsigned pk8_fp4(float4 a, float4 b, float sc) {
    unsigned w = 0u;
    w = __builtin_amdgcn_cvt_scalef32_pk_fp4_f32(w, a.x * sc, a.y * sc, 1.0f, 0); w = __builtin_amdgcn_cvt_scalef32_pk_fp4_f32(w, a.z * sc, a.w * sc, 1.0f, 1);
    w = __builtin_amdgcn_cvt_scalef32_pk_fp4_f32(w, b.x * sc, b.y * sc, 1.0f, 2); w = __builtin_amdgcn_cvt_scalef32_pk_fp4_f32(w, b.z * sc, b.w * sc, 1.0f, 3);
    return w; }
__device__ __forceinline__ void peer_gather_token(const unsigned short* XNb, const float* rowss, const unsigned char* U8, const unsigned char* V8, const unsigned short* EXPi, const float* GATEi, float* XS, const float* ngain, unsigned short* Hn, int t, int lane, LAS float* scr) {
    asm volatile("" : "+v"(lane));
    const int eg = lane >> 3, seg = lane & 7;
    LAS float* wact = scr;
    const unsigned idw = ((const unsigned*)(EXPi + (size_t)t * 128))[lane];
    const float gt_e = GATEi[(size_t)t * 128 + 2 * lane], gt_o = GATEi[(size_t)t * 128 + 2 * lane + 1];
    float rs_;
    { const float4* rp = (const float4*)(rowss + (size_t)t * 16); const float4 p0 = rp[0], p1 = rp[1], p2 = rp[2], p3 = rp[3];
      rs_ = (((p0.x + p0.y) + (p0.z + p0.w)) + ((p1.x + p1.y) + (p1.z + p1.w))) + (((p2.x + p2.y) + (p2.z + p2.w)) + ((p3.x + p3.y) + (p3.z + p3.w))); }
    const float xsc = (1.0f / sqrtf(rs_ * (1.0f / D) + EPS)) * (1.0f / U8_SCALE);
    u32x4 xr[4][4];
#pragma unroll
    for (int i = 0; i < 4; ++i) { const unsigned short* xp = XNb + (size_t)t * D + (i * 8 + seg) * 32;
#pragma unroll
        for (int q = 0; q < 4; ++q) xr[i][q] = *(const u32x4*)(xp + 8 * q); }
    auto gid = [&](int g) -> unsigned { const unsigned w = (unsigned)__shfl((int)idw, g * 4 + (eg >> 1)); return (eg & 1) ? (w >> 16) : (w & 0xffffu); };
    auto load_u = [&](unsigned e, u32x4 (&uu)[4]) { const unsigned char* ur = U8 + (size_t)e * (D / 2) + seg * 16;
#pragma unroll
        for (int i = 0; i < 4; ++i) uu[i] = *(const u32x4*)(ur + i * 128); };
    auto dot_u = [&](int g, unsigned e, const u32x4 (&uu)[4]) {
        float s0 = 0.f, s1 = 0.f;
#pragma unroll
        for (int i = 0; i < 4; ++i) {
            const unsigned w[4] = {uu[i].x, uu[i].y, uu[i].z, uu[i].w};
#pragma unroll
            for (int k = 0; k < 4; ++k) {
                const unsigned xw[4] = {xr[i][k].x, xr[i][k].y, xr[i][k].z, xr[i][k].w};
                s0 = dot2bf(xw[0], __builtin_amdgcn_cvt_scalef32_pk_bf16_fp4(w[k], 1.0f, 0), s0);
                s1 = dot2bf(xw[1], __builtin_amdgcn_cvt_scalef32_pk_bf16_fp4(w[k], 1.0f, 1), s1);
                s0 = dot2bf(xw[2], __builtin_amdgcn_cvt_scalef32_pk_bf16_fp4(w[k], 1.0f, 2), s0);
                s1 = dot2bf(xw[3], __builtin_amdgcn_cvt_scalef32_pk_bf16_fp4(w[k], 1.0f, 3), s1);
            }
        }
        float s = (s0 + s1) * xsc;
        s += __shfl_xor(s, 1); s += __shfl_xor(s, 2); s += __shfl_xor(s, 4);
        const float gate_e = __shfl(gt_e, g * 4 + (eg >> 1)), gate_o = __shfl(gt_o, g * 4 + (eg >> 1));
        const float gate = (eg & 1) ? gate_o : gate_e;
        const float ge = 0.5f * s * (1.0f + tanhf(0.7978845608028654f * (s + 0.044715f * s * s * s)));
        if (seg == 0) wact[g * 8 + eg] = ge * gate * (1.0f / V8_SCALE); };
    LAS unsigned short* ids16 = (LAS unsigned short*)(scr + 128);
    ((LAS unsigned*)(scr + 128))[lane] = idw;
    float acc[16];
#pragma unroll
    for (int i = 0; i < 16; ++i) acc[i] = 0.f;
    auto load_v = [&](int g, u32x2 (&vv)[8]) {
#pragma unroll
        for (int j = 0; j < 8; ++j) { const unsigned e = ids16[g * 8 + j]; vv[j] = *(const u32x2*)(V8 + (size_t)e * (D / 2) + lane * 8); } };
    auto fma_v = [&](int g, const u32x2 (&vv)[8]) {
#pragma unroll
        for (int j = 0; j < 8; ++j) {
            __builtin_amdgcn_sched_barrier(0);
            const float a = wact[g * 8 + j];
            const unsigned w[2] = {vv[j].x, vv[j].y};
#pragma unroll
            for (int k = 0; k < 2; ++k) {
                const f32x2_t e0 = __builtin_amdgcn_cvt_scalef32_pk_f32_fp4(w[k], 1.0f, 0), e1 = __builtin_amdgcn_cvt_scalef32_pk_f32_fp4(w[k], 1.0f, 1);
                const f32x2_t e2 = __builtin_amdgcn_cvt_scalef32_pk_f32_fp4(w[k], 1.0f, 2), e3 = __builtin_amdgcn_cvt_scalef32_pk_f32_fp4(w[k], 1.0f, 3);
                acc[8 * k + 0] = fmaf(a, e0.x, acc[8 * k + 0]); acc[8 * k + 1] = fmaf(a, e0.y, acc[8 * k + 1]); acc[8 * k + 2] = fmaf(a, e1.x, acc[8 * k + 2]); acc[8 * k + 3] = fmaf(a, e1.y, acc[8 * k + 3]);
                acc[8 * k + 4] = fmaf(a, e2.x, acc[8 * k + 4]); acc[8 * k + 5] = fmaf(a, e2.y, acc[8 * k + 5]); acc[8 * k + 6] = fmaf(a, e3.x, acc[8 * k + 6]); acc[8 * k + 7] = fmaf(a, e3.y, acc[8 * k + 7]);
            }
        } };
    {
        u32x4 uA[4], uB[4]; u32x2 vA[8], vB[8]; unsigned eA = gid(0), eB;
        load_u(eA, uA);
#pragma unroll 1
        for (int g = 0; g < 16; g += 2) {
            eB = gid(g + 1); load_u(eB, uB);
            load_v(g, vA);
            dot_u(g, eA, uA);
            if (g > 0) fma_v(g - 1, vB);
            if (g + 2 < 16) { eA = gid(g + 2); load_u(eA, uA); }
            load_v(g + 1, vB);
            dot_u(g + 1, eB, uB);
            fma_v(g, vA);
        }
        fma_v(15, vB);
    }
    float ss = 0.f;
    { const u32x4* bp = (const u32x4*)(XNb + (size_t)t * D + lane * 16); const u32x4 b0 = bp[0], b1 = bp[1];
      const unsigned bw[8] = {b0.x, b0.y, b0.z, b0.w, b1.x, b1.y, b1.z, b1.w};
#pragma unroll
      for (int q = 0; q < 8; ++q) { acc[2 * q] += bflo(bw[q]); acc[2 * q + 1] += bfhi(bw[q]); } }
#pragma unroll
    for (int q = 0; q < 16; ++q) ss = fmaf(acc[q], acc[q], ss);
    if (!Hn) {
        float4* o = (float4*)(XS + (size_t)t * D + lane * 16);
#pragma unroll
        for (int q = 0; q < 4; ++q) o[q] = make_float4(acc[4 * q], acc[4 * q + 1], acc[4 * q + 2], acc[4 * q + 3]);
    } else {
        u32x4 x0, x1;
        x0.x = pkbf(acc[0], acc[1]); x0.y = pkbf(acc[2], acc[3]); x0.z = pkbf(acc[4], acc[5]); x0.w = pkbf(acc[6], acc[7]);
        x1.x = pkbf(acc[8], acc[9]); x1.y = pkbf(acc[10], acc[11]); x1.z = pkbf(acc[12], acc[13]); x1.w = pkbf(acc[14], acc[15]);
        u32x4* xo = (u32x4*)(const_cast<unsigned short*>(XNb) + (size_t)t * D + lane * 16); xo[0] = x0; xo[1] = x1;
    }
    if (Hn) {
        ss = wave_sum(ss);
        const float rn = 1.0f / sqrtf(ss * (1.0f / D) + EPS);
        const float4* g4 = (const float4*)(ngain + lane * 16);
        const float4 ga = g4[0], gb = g4[1], gc = g4[2], gd = g4[3];
        u32x4 w0;
        w0.x = pk4_fp8(acc[0] * rn * ga.x, acc[1] * rn * ga.y, acc[2] * rn * ga.z, acc[3] * rn * ga.w); w0.y = pk4_fp8(acc[4] * rn * gb.x, acc[5] * rn * gb.y, acc[6] * rn * gb.z, acc[7] * rn * gb.w);
        w0.z = pk4_fp8(acc[8] * rn * gc.x, acc[9] * rn * gc.y, acc[10] * rn * gc.z, acc[11] * rn * gc.w); w0.w = pk4_fp8(acc[12] * rn * gd.x, acc[13] * rn * gd.y, acc[14] * rn * gd.z, acc[15] * rn * gd.w);
        *(u32x4*)((unsigned char*)Hn + (size_t)t * D + lane * 16) = w0;
    }
}


template <int MODE>
__device__ __forceinline__ void head_prep_task(int task, unsigned short* base, const float* na_gain, const float* dil_gain, const float2* CS) {
    const int h = task & 7, t = (task >> 3) & (T - 1), which = __builtin_amdgcn_readfirstlane(task >> 17);
    unsigned short* p;
    bool do_rope, do_scale; const float* gain = nullptr;
    if (MODE == 0) { p = base + (size_t)t * 2048 + which * 512 + h * 64; do_rope = true; do_scale = (which == 1); }
    else { const int colbase = (which == 0 ? 0 : which == 1 ? 512 : which == 2 ? 1536 : 2048); p = base + (size_t)t * ODD_IN + colbase + h * 64;
           do_rope = which >= 2; do_scale = (which == 0 || which == 2); gain = (which < 2) ? na_gain + which * 64 : dil_gain + (which - 2) * 64; }
    u32x4 w[8];
#pragma unroll
    for (int i = 0; i < 8; ++i) w[i] = ((const u32x4*)p)[i];
    float v[64];
#pragma unroll
    for (int i = 0; i < 8; ++i) { v[8 * i] = bflo(w[i].x); v[8 * i + 1] = bfhi(w[i].x); v[8 * i + 2] = bflo(w[i].y); v[8 * i + 3] = bfhi(w[i].y);
        v[8 * i + 4] = bflo(w[i].z); v[8 * i + 5] = bfhi(w[i].z); v[8 * i + 6] = bflo(w[i].w); v[8 * i + 7] = bfhi(w[i].w); }
    if (MODE == 1) {
        float ss = 0.f;
#pragma unroll
        for (int i = 0; i < 64; ++i) ss = fmaf(v[i], v[i], ss);
        const float r = 1.0f / sqrtf(ss * (1.0f / 64.0f) + EPS);
#pragma unroll
        for (int i = 0; i < 64; ++i) v[i] = v[i] * r * gain[i];
    }
    if (do_rope) {
        const float4* cp = (const float4*)(CS + (size_t)(t & (S - 1)) * 32);
#pragma unroll
        for (int i = 0; i < 16; ++i) { const float4 c2 = cp[i];
            const float a0 = v[2 * i], b0 = v[2 * i + 32], a1 = v[2 * i + 1], b1 = v[2 * i + 33];
            v[2 * i] = a0 * c2.x - b0 * c2.y; v[2 * i + 32] = b0 * c2.x + a0 * c2.y;
            v[2 * i + 1] = a1 * c2.z - b1 * c2.w; v[2 * i + 33] = b1 * c2.z + a1 * c2.w; }
    }
    const float sc = do_scale ? 0.125f : 1.0f;
#pragma unroll
    for (int i = 0; i < 8; ++i) { u32x4 o; o.x = pkbf(v[8 * i] * sc, v[8 * i + 1] * sc); o.y = pkbf(v[8 * i + 2] * sc, v[8 * i + 3] * sc); o.z = pkbf(v[8 * i + 4] * sc, v[8 * i + 5] * sc); o.w = pkbf(v[8 * i + 6] * sc, v[8 * i + 7] * sc);
        ((u32x4*)p)[i] = o; }
}


__device__ __forceinline__ void hy_filters_item(int item, float* smem  , const float* fw1, const float* fb1, const float* fw2, const float* fb2, const float* fw3, const float* fb3,
                                                const float* fw_out, const float* freq, unsigned short* GFf, unsigned short* GFb) {
    const int tid = ltid(), l0 = item * 8;
    float* emb = smem; float* h1 = smem + 8 * 40; float* h2 = h1 + 512; float* h3 = h2 + 512;
    if (tid < 8 * 33) {
        const int pp = tid / 33, k = tid % 33, l = l0 + pp;
        float e;
        if (k == 0) e = (float)l / (float)(S - 1);
        else {
            const int j = (k - 1) & 15;
            const float f = 1e-4f + (float)j * ((15.0f - 1e-4f) / 15.0f);
            const float w = 6.283185307179586f * (float)l / (float)S;
            const float a = f * w;
            e = (k <= 16) ? cosf(a) : -sinf(a);
        }
        emb[pp * 40 + k] = e;
    }
    __syncthreads();
    const int pp = tid >> 6, j = tid & 63;
    { float s = fb1[j];
#pragma unroll 11
      for (int i = 0; i < 33; ++i) s += emb[pp * 40 + i] * fw1[i * 64 + j];
      h1[pp * 64 + j] = sinf(freq[j] * s); }
    __syncthreads();
    { float s = fb2[j];
#pragma unroll 16
      for (int i = 0; i < 64; ++i) s += h1[pp * 64 + i] * fw2[i * 64 + j];
      h2[pp * 64 + j] = sinf(freq[j] * s); }
    __syncthreads();
    { float s = fb3[j];
#pragma unroll 16
      for (int i = 0; i < 64; ++i) s += h2[pp * 64 + i] * fw3[i * 64 + j];
      h3[pp * 64 + j] = sinf(freq[j] * s); }
    __syncthreads();
    const float MAXD = logf(1e-2f) / 0.3f, MIND = logf(1e-2f) / 1.5f;
#pragma unroll 1
    for (int col = tid; col < 2048; col += 512) {
        float acc[8];
#pragma unroll
        for (int q = 0; q < 8; ++q) acc[q] = 0.f;
#pragma unroll 1
        for (int i0 = 0; i0 < 64; i0 += 32) {
            float wv[32];
#pragma unroll
            for (int i = 0; i < 32; ++i) wv[i] = fw_out[(i0 + i) * 2048 + col];
#pragma unroll
            for (int i = 0; i < 32; ++i)
#pragma unroll
                for (int q = 0; q < 8; ++q) acc[q] = fmaf(h3[q * 64 + i0 + i], wv[i], acc[q]);
        }
        const int o = col >> 10, d = (col >> 9) & 1, c = col & 511;
        const float delta = fabsf(MIND + (float)c * ((MAXD - MIND) / 511.0f));
#pragma unroll
        for (int q = 0; q < 8; ++q) { const float tn = (float)(l0 + q) / (float)(S - 1); acc[q] *= expf(-tn * delta) + 0.05f; }
        v4u w; w.x = pk2(acc[0], acc[1]); w.y = pk2(acc[2], acc[3]); w.z = pk2(acc[4], acc[5]); w.w = pk2(acc[6], acc[7]);
        unsigned short* dst = (d ? GFb : GFf) + ((size_t)o * HYC + c) * S + l0;
        *(v4u*)dst = w;
    }
    __syncthreads();
}

constexpr int P0_NFW = 3;
__device__ __forceinline__ void hy_filters_wave(int item, int cw, int lane, LAS float* scr, const float* fw1, const float* fb1, const float* fw2, const float* fb2, const float* fw3, const float* fb3,
                                                const float* fw_out, const float* freq, unsigned short* GFf, unsigned short* GFb) {
    asm volatile("" : "+v"(lane));
    const int l0 = item * 8;
    LAS float* emb = scr; LAS float* h1 = scr + 320; LAS float* h2 = h1 + 512; LAS float* h3 = h2 + 512;
    if (lane < 33) {
#pragma unroll
        for (int pp = 0; pp < 8; ++pp) { const int l = l0 + pp; float e;
            if (lane == 0) e = (float)l / (float)(S - 1);
            else { const int j = (lane - 1) & 15; const float f = 1e-4f + (float)j * ((15.0f - 1e-4f) / 15.0f); const float w = 6.283185307179586f * (float)l / (float)S; const float a = f * w;
                   e = (lane <= 16) ? cosf(a) : -sinf(a); }
            emb[pp * 40 + lane] = e; }
    }
    __builtin_amdgcn_wave_barrier();
    const float fq = freq[lane];
    { float wv[33];
#pragma unroll
      for (int i = 0; i < 33; ++i) wv[i] = fw1[i * 64 + lane];
      const float bb = fb1[lane];
#pragma unroll 1
      for (int pp = 0; pp < 8; ++pp) { float s = bb;
#pragma unroll
          for (int i = 0; i < 33; ++i) s = fmaf(emb[pp * 40 + i], wv[i], s);
          h1[pp * 64 + lane] = sinf(fq * s); } }
    __builtin_amdgcn_wave_barrier();
    { float wv[64];
#pragma unroll
      for (int i = 0; i < 64; ++i) wv[i] = fw2[i * 64 + lane];
      const float bb = fb2[lane];
#pragma unroll 1
      for (int pp = 0; pp < 8; ++pp) { float s = bb;
#pragma unroll
          for (int i = 0; i < 64; ++i) s = fmaf(h1[pp * 64 + i], wv[i], s);
          h2[pp * 64 + lane] = sinf(fq * s); } }
    __builtin_amdgcn_wave_barrier();
    { float wv[64];
#pragma unroll
      for (int i = 0; i < 64; ++i) wv[i] = fw3[i * 64 + lane];
      const float bb = fb3[lane];
#pragma unroll 1
      for (int pp = 0; pp < 8; ++pp) { float s = bb;
#pragma unroll
          for (int i = 0; i < 64; ++i) s = fmaf(h2[pp * 64 + i], wv[i], s);
          h3[pp * 64 + lane] = sinf(fq * s); } }
    __builtin_amdgcn_wave_barrier();
    const float MAXD = logf(1e-2f) / 0.3f, MIND = logf(1e-2f) / 1.5f;
#pragma unroll 1
    for (int col = cw * 64 + lane; col < 2048; col += P0_NFW * 64) {
        float acc[8];
#pragma unroll
        for (int q = 0; q < 8; ++q) acc[q] = 0.f;
#pragma unroll 1
        for (int i0 = 0; i0 < 64; i0 += 32) {
            float wv[32];
#pragma unroll
            for (int i = 0; i < 32; ++i) wv[i] = fw_out[(i0 + i) * 2048 + col];
#pragma unroll
            for (int i = 0; i < 32; ++i)
#pragma unroll
                for (int q = 0; q < 8; ++q) acc[q] = fmaf(h3[q * 64 + i0 + i], wv[i], acc[q]);
        }
        const int o = col >> 10, d = (col >> 9) & 1, c = col & 511;
        const float delta = fabsf(MIND + (float)c * ((MAXD - MIND) / 511.0f));
#pragma unroll
        for (int q = 0; q < 8; ++q) { const float tn = (float)(l0 + q) / (float)(S - 1); acc[q] *= expf(-tn * delta) + 0.05f; }
        v4u w; w.x = pk2(acc[0], acc[1]); w.y = pk2(acc[2], acc[3]); w.z = pk2(acc[4], acc[5]); w.w = pk2(acc[6], acc[7]);
        unsigned short* dst = (d ? GFb : GFf) + ((size_t)o * HYC + c) * S + l0;
        *(v4u*)dst = w;
    }
}

constexpr int HY_ROWV = 2056;
constexpr int HY_VZ_BYTES = 16 * HY_ROWV * 2;
constexpr int HY_GSTRIDE = 8224;
constexpr int HY_GCH = 4 * HY_GSTRIDE;
constexpr int HY_GC_OFF = HY_VZ_BYTES;
constexpr int HY_ZP_OFF = HY_GC_OFF + 2 * HY_GCH;
static_assert(HY_ZP_OFF + 64 <= 147456, "hyena LDS map");

__device__ __forceinline__ void hy_short4(const unsigned short* row, int n0, float w0, float w1, float w2, float bias, float (&o)[4]) {
    const uint2 w = *(const uint2*)(row + n0);
    const float e0 = bflo(w.x), e1 = bfhi(w.x), e2 = bflo(w.y), e3 = bfhi(w.y);
    const float pvl = bf2f(row[n0 > 0 ? n0 - 1 : 0]), nxl = bf2f(row[(n0 + 4 < S) ? n0 + 4 : S - 1]);
    const float pv = n0 > 0 ? pvl : 0.f, nx = (n0 + 4 < S) ? nxl : 0.f;
    o[0] = pv * w0 + e0 * w1 + e1 * w2 + bias; o[1] = e0 * w0 + e1 * w1 + e2 * w2 + bias;
    o[2] = e1 * w0 + e2 * w1 + e3 * w2 + bias; o[3] = e2 * w0 + e3 * w1 + nx * w2 + bias;
}
constexpr int HY_STG_OFF = HY_ZP_OFF + 64;
static_assert(HY_STG_OFF + 8192 <= 147456 - 64, "hyena LDS map (staging)");
__device__ __forceinline__ v4u hy_load_taps(const unsigned short* GFf, const unsigned short* GFb, int o, int c) { const int tid = ltid(); return *(const v4u*)((tid < 256 ? GFf : GFb) + ((size_t)o * HYC + c) * S + (tid & 255) * 8); }
__device__ __forceinline__ void hy_fill_filter(LAS unsigned char* lds, v4u w0, v4u w1) {
    const int tid = ltid();
#pragma unroll 1
    for (int ch = 0; ch < 2; ++ch) {
        const v4u w = ch ? w1 : w0;
        __syncthreads();
        *(LAS v4u*)(lds + HY_STG_OFF + tid * 16) = w;
        __syncthreads();
        const LAS unsigned short* F = (const LAS unsigned short*)(lds + HY_STG_OFF);
        const LAS unsigned short* Bw = F + S;
#pragma unroll 1
        for (int gi = tid; gi < 4 * 1026; gi += 512) {
            const int s = gi / 1026, q = gi % 1026;
            unsigned e[4];
#pragma unroll
            for (int k = 0; k < 4; ++k) { const int x = 4 * (q - 512) - s + k; const int ax = x < 0 ? -x : x; const int cx = ax > 2047 ? 2047 : ax;
                const unsigned v = (x <= 0) ? F[cx] : Bw[cx]; e[k] = (ax > 2047) ? 0u : v; }
            u32x2 wv; wv.x = e[0] | (e[1] << 16); wv.y = e[2] | (e[3] << 16);
            *(LAS u32x2*)(lds + HY_GC_OFF + ch * HY_GCH + s * HY_GSTRIDE + q * 8) = wv;
        }
    }
}
__device__ __forceinline__ void hy_conv_mfma(LAS unsigned char* lds, int wave, int lane, f32x16 (&acc)[2][2]) {
    const int r = lane & 31, hh = lane >> 5, ch = wave >> 2, cg = wave & 3;
#pragma unroll
    for (int a = 0; a < 2; ++a)
#pragma unroll
        for (int b = 0; b < 2; ++b)
#pragma unroll
            for (int i = 0; i < 16; ++i) acc[a][b][i] = 0.f;
    const int a_base = HY_GC_OFF + ch * HY_GCH + (r & 3) * HY_GSTRIDE + (512 + 2 * hh - (r >> 2)) * 8;
    const int b_base = ((ch * 8 + (r & 7)) * HY_ROWV + 64 * (8 * cg + (r >> 3)) + 8 * hh) * 2;
    const int dlo = 8 * cg - 31, dhi = 8 * cg + 7;
#pragma unroll 1
    for (int dl = dlo; dl <= dhi; ++dl) {
        const int sh = -128 * dl;
        bf16x8 A[2][4];
#pragma unroll
        for (int mh = 0; mh < 2; ++mh)
#pragma unroll
            for (int ks = 0; ks < 4; ++ks) {
                const LAS unsigned char* p = lds + (a_base + sh + (4 * ks - 8 * mh) * 8);
                const u32x2 lo = *(const LAS u32x2*)p, hi = *(const LAS u32x2*)(p + 8);
                u32x4 w; w.x = lo.x; w.y = lo.y; w.z = hi.x; w.w = hi.y;
                A[mh][ks] = __builtin_bit_cast(bf16x8, w);
            }
#pragma unroll
        for (int sub = 0; sub < 2; ++sub) {
            if (dl >= 8 * cg + 4 * sub - 31 && dl <= 8 * cg + 4 * sub + 3) {
                const int J = 8 * cg + 4 * sub + (r >> 3) - dl;
                const bool ok = (unsigned)J < 32u;
#pragma unroll
                for (int ks = 0; ks < 4; ++ks) {
                    const int addr = ok ? (b_base + sh + 512 * sub + 32 * ks) : HY_ZP_OFF;
                    const bf16x8 Bf = *(const LAS bf16x8*)(lds + addr);
                    acc[0][sub] = __builtin_amdgcn_mfma_f32_32x32x16_bf16(A[0][ks], Bf, acc[0][sub], 0, 0, 0);
                    acc[1][sub] = __builtin_amdgcn_mfma_f32_32x32x16_bf16(A[1][ks], Bf, acc[1][sub], 0, 0, 0);
                }
            }
        }
    }
}
__device__ __forceinline__ void hy_epilogue(LAS unsigned char* lds, int wave, int lane, const f32x16 (&acc)[2][2], const unsigned short* HYT, int gate_row, float w0, float w1, float w2, float bias, float skip) {
    const int r = lane & 31, hh = lane >> 5, ch = wave >> 2, cg = wave & 3, b = r & 7;
    const unsigned short* grow = HYT + (size_t)gate_row * T + (size_t)b * S;
#pragma unroll
    for (int mh = 0; mh < 2; ++mh)
#pragma unroll
        for (int sub = 0; sub < 2; ++sub)
#pragma unroll
            for (int qd = 0; qd < 4; ++qd) {
                const int I = 8 * cg + 4 * sub + (r >> 3), n0 = 64 * I + 32 * mh + 8 * qd + 4 * hh;
                float g[4]; hy_short4(grow, n0, w0, w1, w2, bias, g);
                LAS u32x2* vp = (LAS u32x2*)(lds + ((ch * 8 + b) * HY_ROWV + n0) * 2);
                const u32x2 vw = *vp;
                const float y0 = acc[mh][sub][4 * qd], y1 = acc[mh][sub][4 * qd + 1], y2 = acc[mh][sub][4 * qd + 2], y3 = acc[mh][sub][4 * qd + 3];
                u32x2 ow;
                ow.x = pk2(g[0] * (y0 + skip * bflo(vw.x)), g[1] * (y1 + skip * bfhi(vw.x)));
                ow.y = pk2(g[2] * (y2 + skip * bflo(vw.y)), g[3] * (y3 + skip * bfhi(vw.y)));
                *vp = ow;
            }
}
__device__ __forceinline__ void hy_unit(int cp, LAS unsigned char* lds, const unsigned short* HYT, const unsigned short* GFf, const unsigned short* GFb,
                                        const float* conv_w, const float* conv_b, const float* skip, unsigned short* MIXb) {
    const int tid = ltid(), lane = tid & 63, wave = __builtin_amdgcn_readfirstlane(tid >> 6);
    const int c0 = 2 * cp;
    if (tid < 16) ((LAS unsigned*)(lds + HY_ZP_OFF))[tid] = 0u;
    const v4u tp00 = hy_load_taps(GFf, GFb, 0, c0), tp01 = hy_load_taps(GFf, GFb, 0, c0 + 1), tp10 = hy_load_taps(GFf, GFb, 1, c0), tp11 = hy_load_taps(GFf, GFb, 1, c0 + 1);
#pragma unroll
    for (int it = 0; it < 8; ++it) {
        const int chunk = it * 512 + tid, ch = chunk >> 11, rem = chunk & 2047, b = rem >> 8, pos0 = (rem & 255) * 8;
        const int c = c0 + ch;
        const float w0 = conv_w[c], w1 = conv_w[HY_IN + c], w2 = conv_w[2 * HY_IN + c], bias = conv_b[c];
        const unsigned short* row = HYT + (size_t)c * T + (size_t)b * S;
        float o0[4], o1[4];
        hy_short4(row, pos0, w0, w1, w2, bias, o0); hy_short4(row, pos0 + 4, w0, w1, w2, bias, o1);
        v4u w; w.x = pk2(o0[0], o0[1]); w.y = pk2(o0[2], o0[3]); w.z = pk2(o1[0], o1[1]); w.w = pk2(o1[2], o1[3]);
        *(LAS v4u*)(lds + ((ch * 8 + b) * HY_ROWV + pos0) * 2) = w;
    }
    hy_fill_filter(lds, tp00, tp01);
    __syncthreads();
    f32x16 acc[2][2];
    hy_conv_mfma(lds, wave, lane, acc);
    __syncthreads();
    {
        const int c = c0 + (wave >> 2), gc = 512 + c;
        hy_epilogue(lds, wave, lane, acc, HYT, gc, conv_w[gc], conv_w[HY_IN + gc], conv_w[2 * HY_IN + gc], conv_b[gc], skip[c]);
    }
    hy_fill_filter(lds, tp10, tp11);
    __syncthreads();
    hy_conv_mfma(lds, wave, lane, acc);
    __syncthreads();
    {
        const int c = c0 + (wave >> 2), gc = 1024 + c;
        hy_epilogue(lds, wave, lane, acc, HYT, gc, conv_w[gc], conv_w[HY_IN + gc], conv_w[2 * HY_IN + gc], conv_b[gc], skip[HYC + c]);
    }
    __syncthreads();
#pragma unroll 1
    for (int t = tid; t < T; t += 512) {
        const int b = t >> 11, pos = t & 2047;
        const unsigned lo = *(const LAS unsigned short*)(lds + ((0 * 8 + b) * HY_ROWV + pos) * 2);
        const unsigned hi = *(const LAS unsigned short*)(lds + ((1 * 8 + b) * HY_ROWV + pos) * 2);
        *(unsigned*)(MIXb + (size_t)t * D + c0) = lo | (hi << 16);
    }
    __syncthreads();
}


typedef __bf16 bf2_t __attribute__((ext_vector_type(2)));
__device__ __forceinline__ int crow32(int i, int hh) { return (i & 3) + 8 * (i >> 2) + 4 * hh; }
constexpr int AT_KT_BYTES = 8192, AT_VT_BYTES = 8192, AT_BUF_BYTES = AT_KT_BYTES + AT_VT_BYTES;
typedef short s16x4_t __attribute__((ext_vector_type(4)));
constexpr int AT_TAB_OFF = 6 * AT_BUF_BYTES;
constexpr int AT_ST_OFF = 40960;
struct AtTile { const unsigned short* K; const unsigned short* V; int pitch; int row0, rstride, rmin, rmax; };

template <class Pol>
__device__ __forceinline__ void attn_unit(Pol& pol, LAS unsigned char* lds) {
    const int tid = ltid(), lane = tid & 63, r = lane & 31, hh = lane >> 5;
    const int skey = tid >> 3, sc = tid & 7;
    const int tq = (lane & 15) >> 2, tp = lane & 3, tblk = (lane >> 4) & 1;
    bf16x8 Qf[4];
    { const unsigned short* qp = pol.qptr(r);
#pragma unroll
      for (int ks = 0; ks < 4; ++ks) Qf[ks] = *(const bf16x8*)(qp + 16 * ks + 8 * hh); }
    f32x16 O[2];
#pragma unroll
    for (int dt = 0; dt < 2; ++dt)
#pragma unroll
        for (int i = 0; i < 16; ++i) O[dt][i] = 0.f;
    float Ls = 0.f;
    if constexpr (Pol::PRE) pol.pre(O, Qf, lds, r, hh);
    const int nt = pol.ntiles();
    u32x4 kA, vA, kB, vB;
    auto g_load = [&](int j, u32x4& kreg, u32x4& vreg) { const AtTile t = pol.tile(j); int row = t.row0 + skey * t.rstride; row = row < t.rmin ? t.rmin : (row > t.rmax ? t.rmax : row);
        kreg = *(const u32x4*)(t.K + (size_t)row * t.pitch + sc * 8); vreg = *(const u32x4*)(t.V + (size_t)row * t.pitch + sc * 8); };
    auto l_store = [&](int buf, int jt, u32x4 kreg, u32x4 vreg) { LAS unsigned char* kt = lds + buf * AT_BUF_BYTES; LAS unsigned char* vt = kt + AT_KT_BYTES;
        if constexpr (Pol::KSCALE) { const float c = pol.kscale(jt, skey);
            kreg.x = pkbf(bflo(kreg.x) * c, bfhi(kreg.x) * c); kreg.y = pkbf(bflo(kreg.y) * c, bfhi(kreg.y) * c); kreg.z = pkbf(bflo(kreg.z) * c, bfhi(kreg.z) * c); kreg.w = pkbf(bflo(kreg.w) * c, bfhi(kreg.w) * c); }
        *(LAS u32x4*)(kt + skey * 128 + ((sc ^ (skey & 7)) * 16)) = kreg;
        *(LAS u32x4*)(vt + skey * 128 + ((sc ^ (((skey >> 1) & 1) << 2)) * 16)) = vreg; };
    auto compute = [&](int j, int buf) {
        if (pol.active(j)) {
            const LAS unsigned char* kt = lds + buf * AT_BUF_BYTES; const LAS unsigned char* vt = kt + AT_KT_BYTES;
            f32x16 Sx[2];
#pragma unroll
            for (int kh = 0; kh < 2; ++kh) {
#pragma unroll
                for (int i = 0; i < 16; ++i) Sx[kh][i] = 0.f;
                const int key = kh * 32 + r;
#pragma unroll
                for (int ks = 0; ks < 4; ++ks) { const bf16x8 A = *(const LAS bf16x8*)(kt + key * 128 + (((2 * ks + hh) ^ (key & 7)) * 16));
                    Sx[kh] = __builtin_amdgcn_mfma_f32_32x32x16_bf16(A, Qf[ks], Sx[kh], 0, 0, 0); }
            }
            bf16x8 Pf[2][2];
            pol.scores(Sx, j, hh, Ls);
#pragma unroll
            for (int kh = 0; kh < 2; ++kh) {
                float pv[16];
#pragma unroll
                for (int i = 0; i < 16; ++i) pv[i] = Sx[kh][i];
#pragma unroll
                for (int s = 0; s < 2; ++s) { u32x4 w; w.x = pkbf(pv[8 * s], pv[8 * s + 1]); w.y = pkbf(pv[8 * s + 2], pv[8 * s + 3]); w.z = pkbf(pv[8 * s + 4], pv[8 * s + 5]); w.w = pkbf(pv[8 * s + 6], pv[8 * s + 7]);
                    Pf[kh][s] = __builtin_bit_cast(bf16x8, w); }
            }
#pragma unroll
            for (int dt = 0; dt < 2; ++dt)
#pragma unroll
                for (int kh = 0; kh < 2; ++kh)
#pragma unroll
                    for (int s = 0; s < 2; ++s) {
                        const int key_lo = kh * 32 + 16 * s + 4 * hh + tq, cch = (4 * dt + 2 * tblk + (tp >> 1)) ^ (((tq >> 1) & 1) << 2);
                        const LAS unsigned char* ap = vt + key_lo * 128 + cch * 16 + (tp & 1) * 8;
                        const s16x4_t lo = __builtin_amdgcn_ds_read_tr16_b64_v4i16((LAS s16x4_t*)ap), hi = __builtin_amdgcn_ds_read_tr16_b64_v4i16((LAS s16x4_t*)(ap + 8 * 128));
                        const bf16x8 A = __builtin_shufflevector(lo, hi, 0, 1, 2, 3, 4, 5, 6, 7);
                        O[dt] = __builtin_amdgcn_mfma_f32_32x32x16_bf16(A, Pf[kh][s], O[dt], 0, 0, 0); }
        } };
    if constexpr (Pol::RESIDENT) {
        constexpr int NT = Pol::NT;
        const int nt = pol.ntiles();
        u32x4 kr[NT], vr[NT];
#pragma unroll
        for (int j = 0; j < NT; ++j) g_load(j < nt ? j : nt - 1, kr[j], vr[j]);
#pragma unroll 1
        for (int b0 = 0; b0 < nt; b0 += NT) {
            __syncthreads();
#pragma unroll
            for (int j = 0; j < NT; ++j) l_store(j, b0 + j, kr[j], vr[j]);
            if (b0 + NT < nt) {
#pragma unroll
                for (int j = 0; j < NT; ++j) { const int jn = b0 + NT + j; g_load(jn < nt ? jn : nt - 1, kr[j], vr[j]); }
            }
            __syncthreads();
#pragma unroll 1
            for (int j = 0; j < NT; ++j) if (b0 + j < nt) compute(b0 + j, j);
        }
        Ls += __shfl_xor(Ls, 32);
        pol.finish(O, Ls, r, hh);
        return;
    }
    g_load(0, kA, vA); l_store(0, 0, kA, vA);
    if (nt > 1) g_load(1, kA, vA);
    __syncthreads();
#pragma unroll 1
    for (int j = 0; j < nt; j += 2) {
        if (j + 2 < nt) g_load(j + 2, kB, vB);
        compute(j, j & 1);
        if (j + 1 < nt) l_store((j + 1) & 1, j + 1, kA, vA);
        __syncthreads();
        if (j + 1 >= nt) break;
        if (j + 3 < nt) g_load(j + 3, kA, vA);
        compute(j + 1, (j + 1) & 1);
        if (j + 2 < nt) l_store((j + 2) & 1, j + 2, kB, vB);
        __syncthreads();
    }
    Ls += __shfl_xor(Ls, 32);
    pol.finish(O, Ls, r, hh);
}

__device__ __forceinline__ void ret_kv_unit(int item, const unsigned short* RET, const float* log_decay, float* LT, LAS unsigned char* lds) {
    const int tid = ltid(), lane = tid & 63, wave = __builtin_amdgcn_readfirstlane(tid >> 6), r = lane & 31, hh = lane >> 5;
    const int tq = (lane & 15) >> 2, tp = lane & 3, tblk = (lane >> 4) & 1;
    const int b = item >> 6, h = (item >> 3) & 7, c = item & 7;
    const float lgf2 = -expf(log_decay[h]) * 1.4426950408889634f, lgb2 = -expf(log_decay[8 + h]) * 1.4426950408889634f;
    {
        const int key = tid >> 1, ch0 = (tid & 1) * 4, skey = key & 63;
        const unsigned short* kp = RET + (size_t)(b * S + c * 256 + key) * 2048 + 512 + h * 64 + ch0 * 8;
        const float ff = __builtin_amdgcn_exp2f(lgf2 * (float)(255 - key)), fb = __builtin_amdgcn_exp2f(lgb2 * (float)key);
        u32x4 kr[4], vr[4];
#pragma unroll
        for (int i = 0; i < 4; ++i) { kr[i] = ((const u32x4*)kp)[i]; vr[i] = ((const u32x4*)(kp + 512))[i]; }
#pragma unroll
        for (int i = 0; i < 4; ++i) { const int so = (key >> 6) * 8192 + skey * 128 + (((ch0 + i) ^ (((skey >> 1) & 1) << 2)) * 16);
            const unsigned x = kr[i].x, y = kr[i].y, z = kr[i].z, w = kr[i].w;
            u32x4 kf, kb; kf.x = pkbf(bflo(x) * ff, bfhi(x) * ff); kf.y = pkbf(bflo(y) * ff, bfhi(y) * ff); kf.z = pkbf(bflo(z) * ff, bfhi(z) * ff); kf.w = pkbf(bflo(w) * ff, bfhi(w) * ff);
            kb.x = pkbf(bflo(x) * fb, bfhi(x) * fb); kb.y = pkbf(bflo(y) * fb, bfhi(y) * fb); kb.z = pkbf(bflo(z) * fb, bfhi(z) * fb); kb.w = pkbf(bflo(w) * fb, bfhi(w) * fb);
            *(LAS u32x4*)(lds + so) = kf; *(LAS u32x4*)(lds + 32768 + so) = kb; *(LAS u32x4*)(lds + 65536 + so) = vr[i]; }
    }
    __syncthreads();
    const int dir = wave >> 2, eb = (wave >> 1) & 1, db = wave & 1;
    const LAS unsigned char* kt = lds + dir * 32768; const LAS unsigned char* vt = lds + 65536;
    f32x16 acc;
#pragma unroll
    for (int i = 0; i < 16; ++i) acc[i] = 0.f;
    const int swz = ((tq >> 1) & 1) << 2;
#pragma unroll
    for (int st = 0; st < 4; ++st)
#pragma unroll
        for (int g = 0; g < 4; ++g) {
            const int key_lo = 16 * g + 4 * hh + tq;
            const LAS unsigned char* ap = kt + st * 8192 + key_lo * 128 + (((4 * eb + 2 * tblk + (tp >> 1)) ^ swz) * 16) + (tp & 1) * 8;
            const LAS unsigned char* bp = vt + st * 8192 + key_lo * 128 + (((4 * db + 2 * tblk + (tp >> 1)) ^ swz) * 16) + (tp & 1) * 8;
            const s16x4_t alo = __builtin_amdgcn_ds_read_tr16_b64_v4i16((LAS s16x4_t*)ap), ahi = __builtin_amdgcn_ds_read_tr16_b64_v4i16((LAS s16x4_t*)(ap + 8 * 128));
            const s16x4_t blo = __builtin_amdgcn_ds_read_tr16_b64_v4i16((LAS s16x4_t*)bp), bhi = __builtin_amdgcn_ds_read_tr16_b64_v4i16((LAS s16x4_t*)(bp + 8 * 128));
            const bf16x8 A = __builtin_shufflevector(alo, ahi, 0, 1, 2, 3, 4, 5, 6, 7), B = __builtin_shufflevector(blo, bhi, 0, 1, 2, 3, 4, 5, 6, 7);
            acc = __builtin_amdgcn_mfma_f32_32x32x16_bf16(A, B, acc, 0, 0, 0); }
    float* out = LT + ((size_t)item * 2 + dir) * 4096 + (32 * db + r) * 64 + 32 * eb + 4 * hh;
#pragma unroll
    for (int g = 0; g < 4; ++g) *(float4*)(out + 8 * g) = make_float4(acc[4 * g], acc[4 * g + 1], acc[4 * g + 2], acc[4 * g + 3]);
    __syncthreads();
}
struct RetPol {
    const unsigned short* RET; const float* gn_gain; unsigned short* MIXb; const float* LT; int b, h, q0; float lgf2, lgb2; int qpos;
    __device__ __forceinline__ void init(int unit, const unsigned short* RET_, const float* log_decay, const float* gn, unsigned short* MIXb_, const float* LT_) {
        RET = RET_; gn_gain = gn; MIXb = MIXb_; LT = LT_; b = unit >> 6; h = (unit >> 3) & 7; q0 = (unit & 7) * 256;
        lgf2 = -expf(log_decay[h]) * 1.4426950408889634f; lgb2 = -expf(log_decay[8 + h]) * 1.4426950408889634f;
        qpos = q0 + (ltid() >> 6) * 32 + (ltid() & 31);
    }
    __device__ __forceinline__ const unsigned short* qptr(int) const { return RET + (size_t)(b * S + qpos) * 2048 + h * 64; }
    __device__ __forceinline__ int ntiles() const { return 4; }
    __device__ __forceinline__ AtTile tile(int j) const { return AtTile{RET + 512 + h * 64, RET + 1024 + h * 64, 2048, b * S + q0 + 64 * j, 1, 0, T - 1}; }
    __device__ __forceinline__ bool active(int) const { return true; }
    static constexpr bool KSCALE = false, PRE = true, RESIDENT = false;
    __device__ __forceinline__ float kscale(int, int) const { return 1.0f; }
    __device__ __forceinline__ void scores(f32x16 (&Sx)[2], int j, int hh, float&) const {
        const int qk = qpos - q0 - 64 * j;
#pragma unroll
        for (int kh = 0; kh < 2; ++kh)
#pragma unroll
            for (int i = 0; i < 16; ++i) { const int diff = qk - (kh * 32 + crow32(i, hh)); const float e = diff >= 0 ? lgf2 * (float)diff : -lgb2 * (float)diff;
                const float sv = Sx[kh][i]; Sx[kh][i] = sv * __builtin_amdgcn_exp2f(e); }
    }
    __device__ __forceinline__ void pre(f32x16 (&O)[2], const bf16x8 (&Qf)[4], LAS unsigned char* lds, int r, int hh) const {
        LAS unsigned char* st = lds + AT_ST_OFF;
        {   const int tid = ltid(), d = tid >> 3, ech = tid & 7, c = q0 >> 8;
            const float* base = LT + (size_t)((b * 8 + h) * 8) * 8192 + d * 64 + ech * 8;
            float4 af0 = make_float4(0.f, 0.f, 0.f, 0.f), af1 = af0, ab0 = af0, ab1 = af0;
#pragma unroll
            for (int k = 1; k < 8; ++k) { const int cp = (c + k) & 7; const bool bw = cp > c; const int dist = bw ? cp - c : c - cp;
                const float w = __builtin_amdgcn_exp2f((bw ? lgb2 : lgf2) * (float)(256 * dist - 255)), wf = bw ? 0.f : w, wb = bw ? w : 0.f;
                const float4* p = (const float4*)(base + (size_t)(cp * 2 + (bw ? 1 : 0)) * 4096); const float4 x0 = p[0], x1 = p[1];
                af0.x = fmaf(wf, x0.x, af0.x); af0.y = fmaf(wf, x0.y, af0.y); af0.z = fmaf(wf, x0.z, af0.z); af0.w = fmaf(wf, x0.w, af0.w);
                af1.x = fmaf(wf, x1.x, af1.x); af1.y = fmaf(wf, x1.y, af1.y); af1.z = fmaf(wf, x1.z, af1.z); af1.w = fmaf(wf, x1.w, af1.w);
                ab0.x = fmaf(wb, x0.x, ab0.x); ab0.y = fmaf(wb, x0.y, ab0.y); ab0.z = fmaf(wb, x0.z, ab0.z); ab0.w = fmaf(wb, x0.w, ab0.w);
                ab1.x = fmaf(wb, x1.x, ab1.x); ab1.y = fmaf(wb, x1.y, ab1.y); ab1.z = fmaf(wb, x1.z, ab1.z); ab1.w = fmaf(wb, x1.w, ab1.w); }
            u32x4 wfv, wbv; wfv.x = pkbf(af0.x, af0.y); wfv.y = pkbf(af0.z, af0.w); wfv.z = pkbf(af1.x, af1.y); wfv.w = pkbf(af1.z, af1.w);
            wbv.x = pkbf(ab0.x, ab0.y); wbv.y = pkbf(ab0.z, ab0.w); wbv.z = pkbf(ab1.x, ab1.y); wbv.w = pkbf(ab1.z, ab1.w);
            const int so = d * 128 + ((ech ^ (d & 7)) * 16);
            *(LAS u32x4*)(st + so) = wfv; *(LAS u32x4*)(st + 8192 + so) = wbv; }
        __syncthreads();
#pragma unroll
        for (int dir = 0; dir < 2; ++dir) {
            const float qs = dir ? __builtin_amdgcn_exp2f(lgb2 * (float)(q0 + 255 - qpos)) : __builtin_amdgcn_exp2f(lgf2 * (float)(qpos - q0));
#pragma unroll
            for (int ks = 0; ks < 4; ++ks) { const u32x4 qw = __builtin_bit_cast(u32x4, Qf[ks]); const unsigned x = qw.x, y = qw.y, z = qw.z, w = qw.w;
                u32x4 sw; sw.x = pkbf(bflo(x) * qs, bfhi(x) * qs); sw.y = pkbf(bflo(y) * qs, bfhi(y) * qs); sw.z = pkbf(bflo(z) * qs, bfhi(z) * qs); sw.w = pkbf(bflo(w) * qs, bfhi(w) * qs);
                const bf16x8 Qs = __builtin_bit_cast(bf16x8, sw);
#pragma unroll
                for (int dt = 0; dt < 2; ++dt) { const int row = 32 * dt + r;
                    const bf16x8 A = *(const LAS bf16x8*)(st + dir * 8192 + row * 128 + (((2 * ks + hh) ^ (row & 7)) * 16));
                    O[dt] = __builtin_amdgcn_mfma_f32_32x32x16_bf16(A, Qs, O[dt], 0, 0, 0); } }
        }
    }
    __device__ __forceinline__ void finish(const f32x16 (&O)[2], float, int, int hh) const {
        float ss = 0.f;
#pragma unroll
        for (int dt = 0; dt < 2; ++dt)
#pragma unroll
            for (int i = 0; i < 16; ++i) ss = fmaf(O[dt][i], O[dt][i], ss);
        ss += __shfl_xor(ss, 32);
        const float rs = 1.0f / sqrtf(ss * (1.0f / 64.0f) + EPS);
        const size_t t = (size_t)b * S + qpos;
#pragma unroll
        for (int dt = 0; dt < 2; ++dt)
#pragma unroll
            for (int qd = 0; qd < 4; ++qd) { const int d = 32 * dt + 8 * qd + 4 * hh;
                const uint2 gw = *(const uint2*)(RET + t * 2048 + 1536 + h * 64 + d);
                const float4 gg = *(const float4*)(gn_gain + h * 64 + d);
                const float g0 = bflo(gw.x), g1 = bfhi(gw.x), g2 = bflo(gw.y), g3 = bfhi(gw.y);
                const float o0 = g0 / (1.0f + __expf(-g0)) * (O[dt][4 * qd] * rs * gg.x), o1 = g1 / (1.0f + __expf(-g1)) * (O[dt][4 * qd + 1] * rs * gg.y);
                const float o2 = g2 / (1.0f + __expf(-g2)) * (O[dt][4 * qd + 2] * rs * gg.z), o3 = g3 / (1.0f + __expf(-g3)) * (O[dt][4 * qd + 3] * rs * gg.w);
                uint2 ow; ow.x = pkbf(o0, o1); ow.y = pkbf(o2, o3);
                *(uint2*)(MIXb + t * D + 512 + h * 64 + d) = ow; }
    }
};

struct NaPol {
    static constexpr bool KSCALE = false, PRE = false, RESIDENT = true; static constexpr int NT = 6;
    __device__ __forceinline__ void scores(f32x16 (&Sx)[2], int j, int hh, float& Ls) const {
#pragma unroll
        for (int kh = 0; kh < 2; ++kh)
#pragma unroll
            for (int i = 0; i < 16; ++i) { const float sv = Sx[kh][i]; const float pvv = score(sv, kh * 32 + crow32(i, hh), j); Sx[kh][i] = pvv; Ls += pvv; }
    }
    const unsigned short* PJ; unsigned short* MIXb; const LAS float* btab; int b, h, g4, kr_lo, nt_, qrow, qcol, r0, c0;
    __device__ __forceinline__ void init(int unit, const unsigned short* PJ_, unsigned short* MIXb_, const LAS float* btab_) {
        PJ = PJ_; MIXb = MIXb_; btab = btab_; b = unit >> 6; h = (unit >> 3) & 7; g4 = unit & 7;
        const int w = ltid() >> 6;
        qrow = 4 * g4 + (w >> 1); qcol = (w & 1) * 32 + (ltid() & 31);
        r0 = qrow - 4; r0 = r0 < 0 ? 0 : (r0 > 24 ? 24 : r0);
        c0 = qcol - 8; c0 = c0 < 0 ? 0 : (c0 > 48 ? 48 : c0);
        int lo = 4 * g4 - 4; lo = lo < 0 ? 0 : (lo > 24 ? 24 : lo);
        int hi = 4 * g4 + 3 - 4; hi = hi < 0 ? 0 : (hi > 24 ? 24 : hi);
        kr_lo = lo; nt_ = hi + 7 - lo + 1;
    }
    __device__ __forceinline__ const unsigned short* qptr(int) const { return PJ + (size_t)(b * S + qrow * 64 + qcol) * ODD_IN + h * 64; }
    __device__ __forceinline__ int ntiles() const { return nt_; }
    __device__ __forceinline__ AtTile tile(int j) const { return AtTile{PJ + 512 + h * 64, PJ + 1024 + h * 64, ODD_IN, b * S + (kr_lo + j) * 64, 1, 0, T - 1}; }
    __device__ __forceinline__ bool active(int j) const { const int kr = kr_lo + j; const int rr = __builtin_amdgcn_readfirstlane(r0); return kr >= rr && kr <= rr + 7; }
    __device__ __forceinline__ float score(float s, int kk, int j) const {
        const int kr = kr_lo + j; const bool valid = (kk >= c0) && (kk < c0 + 16);
        int ci = kk - qcol + 15; ci = ci < 0 ? 0 : (ci > 30 ? 30 : ci);
        const float bias = btab[(kr - qrow + 7) * 31 + ci];
        return valid ? __builtin_amdgcn_exp2f((s + bias) * 1.4426950408889634f) : 0.f; }
    __device__ __forceinline__ void finish(const f32x16 (&O)[2], float L, int, int hh) const {
        const float il = 1.0f / L; const size_t t = (size_t)b * S + qrow * 64 + qcol;
#pragma unroll
        for (int dt = 0; dt < 2; ++dt)
#pragma unroll
            for (int qd = 0; qd < 4; ++qd) { const int d = 32 * dt + 8 * qd + 4 * hh;
                *(unsigned*)((unsigned char*)MIXb + t * D + h * 64 + d) = pk4_fp8(O[dt][4 * qd] * il, O[dt][4 * qd + 1] * il, O[dt][4 * qd + 2] * il, O[dt][4 * qd + 3] * il); }
    }
};

template <int DIL>
struct DilPolB {
    static constexpr bool KSCALE = false, PRE = false, RESIDENT = true; static constexpr int NT = (DIL == 16 ? 4 : 6);
    __device__ __forceinline__ void scores(f32x16 (&Sx)[2], int j, int hh, float& Ls) const {
#pragma unroll
        for (int kh = 0; kh < 2; ++kh)
#pragma unroll
            for (int i = 0; i < 16; ++i) { const float sv = Sx[kh][i]; const float pvv = score(sv, kh * 32 + crow32(i, hh), j); Sx[kh][i] = pvv; Ls += pvv; }
    }
    const unsigned short* PJ; unsigned short* MIXb; float* PO_w; float* PL_w; const float* PO1; const float* PO2; const float* PL1; const float* PL2;
    int b, h, cls, qsub, wqs, ks0, unit_cls0;
    static constexpr int LS = S / DIL;
    __device__ __forceinline__ void init(int unit, const unsigned short* PJ_, unsigned short* MIXb_, float* PO_w_, float* PL_w_, const float* PO1_, const float* PO2_, const float* PL1_, const float* PL2_) {
        PJ = PJ_; MIXb = MIXb_; PO_w = PO_w_; PL_w = PL_w_; PO1 = PO1_; PO2 = PO2_; PL1 = PL1_; PL2 = PL2_;
        b = unit >> 6; h = (unit >> 3) & 7; const int sub = unit & 7; const int w = ltid() >> 6, r = ltid() & 31;
        if (DIL == 1) { cls = 0; unit_cls0 = 0; wqs = sub * 256 + w * 32; ks0 = sub * 256 - 64; }
        else if (DIL == 4) { cls = sub >> 1; unit_cls0 = cls; wqs = (sub & 1) * 256 + w * 32; ks0 = (sub & 1) * 256 - 64; }
        else { unit_cls0 = 2 * sub; cls = 2 * sub + (w >> 2); wqs = 32 * (w & 3); ks0 = 0; }
        qsub = wqs + r;
    }
    __device__ __forceinline__ int qtok() const { return b * S + DIL * qsub + cls; }
    __device__ __forceinline__ const unsigned short* qptr(int) const { return PJ + (size_t)qtok() * ODD_IN + 1536 + h * 64; }
    __device__ __forceinline__ int ntiles() const { return DIL == 16 ? 4 : 6; }
    __device__ __forceinline__ int tcls(int j) const { return DIL == 16 ? unit_cls0 + (j >> 1) : unit_cls0; }
    __device__ __forceinline__ int tks(int j) const { return DIL == 16 ? 64 * (j & 1) : ks0 + 64 * j; }
    __device__ __forceinline__ AtTile tile(int j) const { return AtTile{PJ + 2048 + h * 64, PJ + 2560 + h * 64, ODD_IN, b * S + DIL * tks(j) + tcls(j), DIL, b * S, b * S + S - 1}; }
    __device__ __forceinline__ bool active(int j) const { const int k0 = tks(j); const int wl = __builtin_amdgcn_readfirstlane(wqs), wc = __builtin_amdgcn_readfirstlane(cls);
        return (tcls(j) == wc) && (k0 <= wl + 31 + 64) && (k0 + 63 >= wl - 64) && (k0 + 63 >= 0) && (k0 < LS); }
    __device__ __forceinline__ float score(float s, int kk, int j) const { const int ksub = tks(j) + kk, diff = qsub - ksub, ad = diff < 0 ? -diff : diff;
        const bool valid = (ksub >= 0) && (ksub < LS) && (ad <= 64);
        return valid ? __builtin_amdgcn_exp2f(s * 1.4426950408889634f) : 0.f; }
    __device__ __forceinline__ void finish(const f32x16 (&O)[2], float L, int, int hh) const {
        const size_t th = (size_t)qtok() * 8 + h;
        if (DIL != 16) {
            if (hh == 0) PL_w[th] = L;
#pragma unroll
            for (int dt = 0; dt < 2; ++dt)
#pragma unroll
                for (int qd = 0; qd < 4; ++qd) { const int d = 32 * dt + 8 * qd + 4 * hh;
                    uint2 pw; pw.x = pkbf(O[dt][4 * qd], O[dt][4 * qd + 1]); pw.y = pkbf(O[dt][4 * qd + 2], O[dt][4 * qd + 3]); *(uint2*)((unsigned short*)PO_w + th * 64 + d) = pw; }
        } else {
            const float il = 1.0f / (L + PL1[th] + PL2[th]);
#pragma unroll
            for (int dt = 0; dt < 2; ++dt)
#pragma unroll
                for (int qd = 0; qd < 4; ++qd) { const int d = 32 * dt + 8 * qd + 4 * hh;
                    const uint2 aw = *(const uint2*)((const unsigned short*)PO1 + th * 64 + d), cw = *(const uint2*)((const unsigned short*)PO2 + th * 64 + d);
                    *(unsigned*)((unsigned char*)MIXb + (size_t)qtok() * D + 512 + h * 64 + d) = pk4_fp8((O[dt][4 * qd] + bflo(aw.x) + bflo(cw.x)) * il, (O[dt][4 * qd + 1] + bfhi(aw.x) + bfhi(cw.x)) * il,
                                                                                                                   (O[dt][4 * qd + 2] + bflo(aw.y) + bflo(cw.y)) * il, (O[dt][4 * qd + 3] + bfhi(aw.y) + bfhi(cw.y)) * il); }
        }
    }
};

__device__ __forceinline__ void p0_transpose_item(const float* W, int K, int N, bf16* WT, const float* kscale, LAS float* scr, int item, int lane) {
    const int nblk = N / 32, kb = item / nblk, nb = item % nblk, k0 = 64 * kb, n0 = 32 * nb;
    { float wv[32];
#pragma unroll
      for (int i = 0; i < 32; ++i) { const int kk = 2 * i + (lane >> 5); wv[i] = __builtin_nontemporal_load(W + (size_t)(k0 + kk) * N + n0 + (lane & 31)); }
#pragma unroll
      for (int i = 0; i < 32; ++i) { const int kk = 2 * i + (lane >> 5); float w = wv[i]; if (kscale) w *= kscale[k0 + kk]; scr[kk * 33 + (lane & 31)] = w; } }
    asm volatile("s_waitcnt lgkmcnt(0)" ::: "memory");
    const int c = lane & 7;
#pragma unroll
    for (int j = 0; j < 4; ++j) { const int n = (lane >> 3) + 8 * j; const LAS float* s = scr + (8 * c) * 33 + n;
        v4u o; o.x = pk2(s[0 * 33], s[1 * 33]); o.y = pk2(s[2 * 33], s[3 * 33]); o.z = pk2(s[4 * 33], s[5 * 33]); o.w = pk2(s[6 * 33], s[7 * 33]);
        *(v4u*)(WT + (size_t)(n0 + n) * K + k0 + 8 * c) = o; }
    asm volatile("s_waitcnt lgkmcnt(0)" ::: "memory");
}

__device__ __forceinline__ void p0_transpose_item_f8(const float* W, int K, int N, unsigned char* WT8, LAS float* scr, int item, int lane) {
    const int nblk = N / 32, kb = item / nblk, nb = item % nblk, k0 = 64 * kb, n0 = 32 * nb;
    { float wv[32];
#pragma unroll
      for (int i = 0; i < 32; ++i) { const int kk = 2 * i + (lane >> 5); wv[i] = __builtin_nontemporal_load(W + (size_t)(k0 + kk) * N + n0 + (lane & 31)); }
#pragma unroll
      for (int i = 0; i < 32; ++i) { const int kk = 2 * i + (lane >> 5); scr[kk * 33 + (lane & 31)] = wv[i] * W8_SCALE; } }
    asm volatile("s_waitcnt lgkmcnt(0)" ::: "memory");
    const int c = lane & 7;
#pragma unroll
    for (int j = 0; j < 4; ++j) { const int n = (lane >> 3) + 8 * j; const LAS float* sp = scr + (8 * c) * 33 + n;
        uint2 o; o.x = pk4_fp8(sp[0 * 33], sp[1 * 33], sp[2 * 33], sp[3 * 33]); o.y = pk4_fp8(sp[4 * 33], sp[5 * 33], sp[6 * 33], sp[7 * 33]);
        *(uint2*)(WT8 + (size_t)(n0 + n) * K + k0 + 8 * c) = o; }
    asm volatile("s_waitcnt lgkmcnt(0)" ::: "memory");
}

#define XB_TMO      128
#define XB_XCNT(j)  (256  + 64 * (j))
#define XB_XSUB(j)  (1280 + 64 * (j))
#define XB_XGEN(j)  (2304 + 64 * (j))
#define XB_TOP      3328
#define XB_TOPGEN   3392
#define XCD_BAR_WORDS 3456
#define XB_SPIN_CAP (1u << 18)

__device__ __forceinline__ unsigned xb_ld(unsigned* p)              { return __hip_atomic_load(p, __ATOMIC_RELAXED, __HIP_MEMORY_SCOPE_AGENT); }
__device__ __forceinline__ unsigned xb_add(unsigned* p, unsigned v) { return __hip_atomic_fetch_add(p, v, __ATOMIC_RELAXED, __HIP_MEMORY_SCOPE_AGENT); }
__device__ __forceinline__ unsigned xb_xcc_id() { return (unsigned)__builtin_amdgcn_s_getreg((3 << 11) | 20) & 0xFu; }
#define XB_SPIN(cond, bar) do { unsigned _sp = 0; while (cond) { __builtin_amdgcn_s_sleep(1); \
    if ((++_sp & 255u) == 0u) { if (xb_ld(&(bar)[XB_TMO])) break; if (_sp > XB_SPIN_CAP) { atomicAdd(&(bar)[XB_TMO], 1u); break; } } } } while (0)

struct XcdBarrier {
    unsigned* bar; unsigned x;
    volatile LAS unsigned* st;
};

__device__ __forceinline__ XcdBarrier xcd_barrier_post(unsigned* bar, volatile LAS unsigned* st) {
    XcdBarrier b; b.bar = bar; b.x = xb_xcc_id(); b.st = st;
    if (ltid() == 0) (void)xb_add(&bar[XB_XCNT(b.x)], 1u);
    return b;
}
__device__ __forceinline__ void xcd_barrier_complete(unsigned* bar, unsigned x, unsigned& nloc, unsigned& nx) {
    const unsigned G = gridDim.x * gridDim.y * gridDim.z;
    unsigned sum, cnt, mine, sp = 0u;
    for (;;) {
        sum = 0u; cnt = 0u; mine = 0u;
#pragma unroll
        for (unsigned j = 0; j < 16; ++j) { const unsigned c = xb_ld(&bar[XB_XCNT(j)]); sum += c; cnt += (c > 0u) ? 1u : 0u; mine = (j == x) ? c : mine; }
        if (sum == G) break;
        __builtin_amdgcn_s_sleep(1);
        if ((++sp & 255u) == 0u) { if (xb_ld(&bar[XB_TMO])) break; if (sp > XB_SPIN_CAP) { atomicAdd(&bar[XB_TMO], 1u); break; } }
    }
    nloc = mine > 0u ? mine : 1u; nx = cnt > 0u ? cnt : 1u;
}

__device__ __forceinline__ void xcd_barrier(const XcdBarrier& b) {
    asm volatile("s_waitcnt vmcnt(0)" ::: "memory");
    __syncthreads();
    if (ltid() == 0) {
        unsigned* bar = b.bar;
        __builtin_amdgcn_s_waitcnt(0);
        unsigned nloc = b.st[0], nx = b.st[1];
        if (nloc == 0u) { xcd_barrier_complete(bar, b.x, nloc, nx); b.st[0] = nloc; b.st[1] = nx; }
        const unsigned old = xb_add(&bar[XB_XSUB(b.x)], 1u);
        const unsigned gen = old / nloc;
        if (old + 1u == (gen + 1u) * nloc) {
            __builtin_amdgcn_fence(__ATOMIC_RELEASE, "agent");
            asm volatile("s_waitcnt vmcnt(0)" ::: "memory");
            const unsigned og = xb_add(&bar[XB_TOP], 1u);
            const unsigned tg = og / nx;
            if (og + 1u == (tg + 1u) * nx) xb_add(&bar[XB_TOPGEN], 1u);
            else XB_SPIN(xb_ld(&bar[XB_TOPGEN]) == tg, bar);
            __builtin_amdgcn_fence(__ATOMIC_ACQUIRE, "agent");
            xb_add(&bar[XB_XGEN(b.x)], 1u);
            asm volatile("s_waitcnt vmcnt(0)" ::: "memory");
        } else {
            XB_SPIN(xb_ld(&bar[XB_XGEN(b.x)]) == gen, bar);
            __builtin_amdgcn_fence(__ATOMIC_ACQUIRE, "agent");
            asm volatile("s_waitcnt vmcnt(0)" ::: "memory");
        }
    }
    __syncthreads();
}

struct Params {
    const float* in[27];
    float* out; char* ws;
};

#define LOOPVB(nvb, call) do { int tid = ltid() & 255, half = ltid() >> 8; asm volatile("" : "+v"(tid), "+v"(half)); float* smem = (float*)(lds + half * 16384); (void)smem; for (int vb = blockIdx.x * 2 + half; vb < (nvb); vb += gridDim.x * 2) { call; } } while (0)
#define PHASE(nvb, call) do { LOOPVB(nvb, call); xcd_barrier(bar); } while (0)
#define GEMMP(A_, B_, N_, C_, R_) do { pg8::Gemm g{A_, B_, T, N_, D}; pg8::StaticOrder So; So.init(T, N_, (int)gridDim.x, (int)blockIdx.x); pg8::EpiF32R E{C_, N_, R_}; \
        pg8::gemm_phase<pg8::EpiF32R, pg8::StaticOrder, true, true>((PG8_LAS unsigned char*)lds, g, So, E); xcd_barrier(bar); } while (0)

#define GEMMB(A_, B_, N_, O_) do { pg8::Gemm g{A_, B_, T, N_, D}; pg8::StaticOrder So; So.init(T, N_, (int)gridDim.x, (int)blockIdx.x); pg8::EpiBf16<0> E{O_, N_, nullptr, 0, 0, 1.f}; \
        pg8::gemm_phase<pg8::EpiBf16<0>, pg8::StaticOrder, true, true>((PG8_LAS unsigned char*)lds, g, So, E); xcd_barrier(bar); } while (0)

#define UMAP(u_) ((gridDim.x == 256) ? ((((u_) & 7) * 8 + ((u_) >> 8) * 4 + (((u_) >> 6) & 3)) * 8 + (((u_) >> 3) & 7)) : (u_))
__global__ void __launch_bounds__(512, 2) fwd_megakernel(Params p) {
    extern __shared__ __attribute__((aligned(16))) unsigned char lds[];
    { volatile LAS unsigned* st0 = (volatile LAS unsigned*)((LAS unsigned char*)lds + 147456 - 64); if (ltid() < 16) st0[ltid()] = 0u; }
    __syncthreads();
    const XcdBarrier bar = xcd_barrier_post((unsigned*)p.ws, (volatile LAS unsigned*)((LAS unsigned char*)lds + 147456 - 64));
    const float* x = p.in[0]; const float* mix_gain = p.in[1]; const float* ffn_gain = p.in[2]; const float* ev_w_in = p.in[3]; const float* ev_w_out = p.in[4];
    const float* hy_conv_w = p.in[5]; const float* hy_conv_b = p.in[6]; const float* fw1 = p.in[7]; const float* fb1 = p.in[8]; const float* fw2 = p.in[9];
    const float* fb2 = p.in[10]; const float* fw3 = p.in[11]; const float* fb3 = p.in[12]; const float* fw_out = p.in[13]; const float* hy_freq = p.in[14];
    const float* hy_skip = p.in[15]; const float* ret_log_decay = p.in[16]; const float* ret_gn_gain = p.in[17]; const float* od_w_in = p.in[18]; const float* od_w_out = p.in[19];
    const float* na_qk_gain = p.in[20]; const float* na_rpb = p.in[21]; const float* dil_qk_gain = p.in[22]; const float* peer_w_q = p.in[23]; const float* peer_sub_keys = p.in[24];
    const float* peer_u = p.in[25]; const float* peer_v = p.in[26];
    float* XS = p.out;
    char* ws = p.ws; size_t off = 65536;
    auto carve = [&](size_t bytes) { char* q = ws + off; off += (bytes + 255) & ~(size_t)255; return q; };
    float* Z = (float*)carve((size_t)T * 512 * 4);
    float* RSS0 = (float*)carve((size_t)T * 16 * 4); float* RSS1 = (float*)carve((size_t)T * 16 * 4);
    bf16* PROJ = (bf16*)carve((size_t)T * EVEN_IN * 2);
    float* UC = (float*)carve((size_t)T * HY_IN * 4);
    float* MIX = (float*)carve((size_t)T * D * 4);
    float* FILT = (float*)carve((size_t)2 * 2 * S * HYC * 4);
    bf16* EXP = (bf16*)carve((size_t)T * 128 * 2);
    float* GATE = (float*)carve((size_t)T * 128 * 4);
    bf16* SKB = (bf16*)carve((size_t)2 * 8 * 2 * 128 * 64 * 2);
    float2* CS = (float2*)carve((size_t)S * 32 * 8);
    unsigned char* UB = (unsigned char*)carve((size_t)2 * 16384 * D);
    unsigned char* VB = (unsigned char*)carve((size_t)2 * 16384 * D);
    bf16* WT_in0 = (bf16*)carve((size_t)EVEN_IN * D * 2);
    bf16* WT_out0 = (bf16*)carve((size_t)D * D * 2);
    bf16* WT_in1 = (bf16*)carve((size_t)ODD_IN * D * 2);
    bf16* WT_out1 = (bf16*)carve((size_t)D * D * 2);
    bf16* WT_q0 = (bf16*)carve((size_t)D * D * 2);
    bf16* WT_q1 = (bf16*)carve((size_t)D * D * 2);
    bf16* Ab = (bf16*)UC;
    bf16* Qb = Ab + (size_t)T * D;
    bf16* XB = Qb + (size_t)T * D;

#define WV_SETUP const int lane = ltid() & 63; const int wave = __builtin_amdgcn_readfirstlane(ltid() >> 6); const int gw = blockIdx.x * 8 + wave, NGW = gridDim.x * 8; \
    LAS float* wscr = (LAS float*)((LAS unsigned char*)lds + wave * 16384); (void)lane; (void)gw; (void)NGW; (void)wscr;

    bf16* GFf = (bf16*)FILT; bf16* GFb = GFf + (size_t)2 * HYC * S;
    bf16* HYT = PROJ; bf16* RET = PROJ + (size_t)HY_IN * T;
    {
        WV_SETUP
        if (wave < P0_NFW) {
            for (int it = blockIdx.x; it < S / 8; it += gridDim.x) hy_filters_wave(it, wave, lane, wscr, fw1, fb1, fw2, fb2, fw3, fb3, fw_out, hy_freq, GFf, GFb);
            const size_t g0 = (size_t)(blockIdx.x * P0_NFW + wave) * 64 + lane, G0 = (size_t)gridDim.x * (P0_NFW * 64);
            for (size_t i = g0; i < (size_t)S * 32; i += G0) { const int pos = (int)(i >> 5), fi = (int)(i & 31);
                const float inv = powf(10000.0f, -(float)(2 * fi) / 64.0f); const float ang = (float)pos * inv; CS[i] = make_float2(cosf(ang), sinf(ang)); }
            for (size_t i = g0; i < (size_t)2 * 8 * 2 * 128 * 64 / 8; i += G0) {
                const float4 a = ((const float4*)peer_sub_keys)[2 * i], b = ((const float4*)peer_sub_keys)[2 * i + 1]; v4u w; w.x = pk2(a.x, a.y); w.y = pk2(a.z, a.w); w.z = pk2(b.x, b.y); w.w = pk2(b.z, b.w); ((v4u*)SKB)[i] = w; }
        } else {
            const int gw7 = blockIdx.x * (8 - P0_NFW) + (wave - P0_NFW), NGW7 = gridDim.x * (8 - P0_NFW);
            for (int r0 = gw7 * 2; r0 < T; r0 += NGW7 * 2) {
                float4 v[2][4]; float ss[2];
#pragma unroll
                for (int q = 0; q < 2; ++q)
#pragma unroll
                    for (int j = 0; j < 4; ++j) { typedef float f4nt __attribute__((ext_vector_type(4))); const f4nt t4 = __builtin_nontemporal_load((const f4nt*)(x + (size_t)(r0 + q) * D) + lane + 64 * j); v[q][j] = make_float4(t4.x, t4.y, t4.z, t4.w); }
#pragma unroll
                for (int q = 0; q < 2; ++q) { float s = 0.f;
#pragma unroll
                    for (int j = 0; j < 4; ++j) s += (v[q][j].x * v[q][j].x + v[q][j].y * v[q][j].y) + (v[q][j].z * v[q][j].z + v[q][j].w * v[q][j].w);
                    ss[q] = 1.0f / sqrtf(wave_sum(s) * (1.0f / D) + EPS); }
#pragma unroll
                for (int j = 0; j < 4; ++j) { const float4 g = ((const float4*)mix_gain)[lane + 64 * j];
#pragma unroll
                    for (int q = 0; q < 2; ++q) { uint2 w; w.x = pkbf(v[q][j].x * ss[q] * g.x, v[q][j].y * ss[q] * g.y); w.y = pkbf(v[q][j].z * ss[q] * g.z, v[q][j].w * ss[q] * g.w);
                        ((uint2*)(Ab + (size_t)(r0 + q) * D))[lane + 64 * j] = w; } }
            }
            constexpr int I_IN0 = (D / 64) * (EVEN_IN / 32), I_SQ = (D / 64) * (D / 32), I_IN1 = (D / 64) * (ODD_IN / 32);
            constexpr int NITEMS = I_IN0 + I_IN1 + 4 * I_SQ;
            for (int it = gw7; it < NITEMS; it += NGW7) {
                int r = it;
                if (r < I_IN0) { p0_transpose_item(ev_w_in, D, EVEN_IN, WT_in0, nullptr, wscr, r, lane); continue; } r -= I_IN0;
                if (r < I_IN1) { p0_transpose_item_f8(od_w_in, D, ODD_IN, (unsigned char*)WT_in1, wscr, r, lane); continue; } r -= I_IN1;
                if (r < I_SQ) { p0_transpose_item(ev_w_out, D, D, WT_out0, nullptr, wscr, r, lane); continue; } r -= I_SQ;
                if (r < I_SQ) { p0_transpose_item_f8(od_w_out, D, D, (unsigned char*)WT_out1, wscr, r, lane); continue; } r -= I_SQ;
                if (r < I_SQ) { p0_transpose_item(peer_w_q, D, D, WT_q0, ffn_gain, wscr, r, lane); continue; } r -= I_SQ;
                p0_transpose_item(peer_w_q + (size_t)D * D, D, D, WT_q1, ffn_gain + D, wscr, r, lane);
            }
            const size_t gt = (size_t)gw7 * 64 + lane, GT = (size_t)NGW7 * 64;
#pragma unroll 8
            for (size_t pidx = gt; pidx < (size_t)2 * 16384 * D / 8; pidx += GT) {
                typedef float f4nt __attribute__((ext_vector_type(4)));
                const f4nt a0v = __builtin_nontemporal_load((const f4nt*)peer_u + 2 * pidx), a1v = __builtin_nontemporal_load((const f4nt*)peer_u + 2 * pidx + 1);
                float4 a0 = make_float4(a0v.x, a0v.y, a0v.z, a0v.w), a1 = make_float4(a1v.x, a1v.y, a1v.z, a1v.w);
                const float4* gq = (const float4*)(ffn_gain + (pidx >= (size_t)16384 * D / 8 ? D : 0) + (size_t)((pidx * 8) & (D - 1))); const float4 g0 = gq[0], g1 = gq[1];
                a0.x *= g0.x; a0.y *= g0.y; a0.z *= g0.z; a0.w *= g0.w; a1.x *= g1.x; a1.y *= g1.y; a1.z *= g1.z; a1.w *= g1.w;
                ((unsigned*)UB)[pidx] = pk8_fp4(a0, a1, U8_SCALE);
                const f4nt c0v = __builtin_nontemporal_load((const f4nt*)peer_v + 2 * pidx), c1v = __builtin_nontemporal_load((const f4nt*)peer_v + 2 * pidx + 1);
                const float4 c0 = make_float4(c0v.x, c0v.y, c0v.z, c0v.w), c1 = make_float4(c1v.x, c1v.y, c1v.z, c1v.w);
                ((unsigned*)VB)[pidx] = pk8_fp4(c0, c1, V8_SCALE);
            }
        }
    }
    xcd_barrier(bar);
    {
        pg8::Gemm g{WT_in0, Ab, HY_IN, T, D}; pg8::StaticOrder So; So.init(HY_IN, T, (int)gridDim.x, (int)blockIdx.x); pg8::EpiBf16<0> E{HYT, T, nullptr, 0, 0, 1.f};
        pg8::gemm_phase<pg8::EpiBf16<0>, pg8::StaticOrder, true, true>((PG8_LAS unsigned char*)lds, g, So, E);
    }
    {
        pg8::Gemm g{Ab, WT_in0 + (size_t)HY_IN * D, T, 2048, D}; pg8::StaticOrder So; So.init(T, 2048, (int)gridDim.x, (int)blockIdx.x); pg8::EpiHead<0> E{RET, 2048, nullptr, nullptr, (const float*)CS, S - 1, EPS, 1.0f};
        pg8::gemm_phase<pg8::EpiHead<0>, pg8::StaticOrder, true, true>((PG8_LAS unsigned char*)lds, g, So, E);
    }
    xcd_barrier(bar);
    for (int u = blockIdx.x; u < NB * 8 * 8; u += gridDim.x) ret_kv_unit(UMAP(u), RET, ret_log_decay, Z, (LAS unsigned char*)lds);
    xcd_barrier(bar);
    for (int u = blockIdx.x; u < HYC / 2; u += gridDim.x) { const int cp = (gridDim.x == 256) ? ((u & 7) * 32 + (u >> 3)) : u;
        hy_unit(cp, (LAS unsigned char*)lds, HYT, GFf, GFb, hy_conv_w, hy_conv_b, hy_skip, Ab); }
    for (int u = blockIdx.x; u < NB * 8 * 8; u += gridDim.x) { RetPol P; P.init(UMAP(u), RET, ret_log_decay, ret_gn_gain, Ab, Z); attn_unit(P, (LAS unsigned char*)lds); }
    xcd_barrier(bar);
    { pg8::Gemm g{Ab, WT_out0, T, D, D}; pg8::StaticOrder So; So.init(T, D, (int)gridDim.x, (int)blockIdx.x); pg8::EpiResXB<false> E{x, D, XB, RSS0, 1.0f};
      pg8::gemm_phase<pg8::EpiResXB<false>, pg8::StaticOrder, true, true>((PG8_LAS unsigned char*)lds, g, So, E); xcd_barrier(bar); }
    { pg8::Gemm g{XB, WT_q0, T, D, D}; pg8::StaticOrder So; So.init(T, D, (int)gridDim.x, (int)blockIdx.x); EpiQSel E{RSS0, 1.0f / D, EPS, SKB, EXP, GATE}; pg8::Unit uu;
      for (int i = 0; So.next(i, uu); ++i) { const OneUnit Su{uu}; pg8::gemm_phase<EpiQSel, OneUnit, true, true>((PG8_LAS unsigned char*)lds, g, Su, E); }
      xcd_barrier(bar); }
    { WV_SETUP
    for (int t = gw; t < T; t += NGW) peer_gather_token(XB, RSS0, UB, VB, EXP, GATE, XS, mix_gain + D, Ab, t, lane, wscr); }
    xcd_barrier(bar);
    { pg8::Gemm g{Ab, WT_in1, T, ODD_IN, D}; pg8::StaticOrder So; So.init(T, ODD_IN, (int)gridDim.x, (int)blockIdx.x); pg8::EpiHead<1> E{PROJ, ODD_IN, na_qk_gain, dil_qk_gain, (const float*)CS, S - 1, EPS, 1.0f / W8_SCALE};
      pg8::gemm_phase<pg8::EpiHead<1>, pg8::StaticOrder, true, false, true>((PG8_LAS unsigned char*)lds, g, So, E); xcd_barrier(bar); }
    for (int u = blockIdx.x; u < NB * 8 * 8; u += gridDim.x) {
        LAS float* tab = (LAS float*)((LAS unsigned char*)lds + AT_TAB_OFF);
        const int um = UMAP(u);
        __syncthreads();
        if (ltid() < 15 * 31) tab[ltid()] = na_rpb[((um >> 3) & 7) * (15 * 31) + ltid()];
        NaPol P; P.init(um, PROJ, Ab, tab); attn_unit(P, (LAS unsigned char*)lds);
    }
    {
        float* PO1 = MIX; float* PO2 = MIX + (size_t)T * 512; float* PL1 = Z; float* PL2 = Z + (size_t)T * 8;
        for (int u = blockIdx.x; u < NB * 8 * 8; u += gridDim.x) { DilPolB<1> P; P.init(UMAP(u), PROJ, Ab, PO1, PL1, nullptr, nullptr, nullptr, nullptr); attn_unit(P, (LAS unsigned char*)lds); }
        for (int u = blockIdx.x; u < NB * 8 * 8; u += gridDim.x) { DilPolB<4> P; P.init(UMAP(u), PROJ, Ab, PO2, PL2, nullptr, nullptr, nullptr, nullptr); attn_unit(P, (LAS unsigned char*)lds); }
        xcd_barrier(bar);
        for (int u = blockIdx.x; u < NB * 8 * 8; u += gridDim.x) { DilPolB<16> P; P.init(UMAP(u), PROJ, Ab, nullptr, nullptr, PO1, PO2, PL1, PL2); attn_unit(P, (LAS unsigned char*)lds); }
    }
    xcd_barrier(bar);
    { pg8::Gemm g{Ab, WT_out1, T, D, D}; pg8::StaticOrder So; So.init(T, D, (int)gridDim.x, (int)blockIdx.x); pg8::EpiResXB<true> E{XB, D, XB, RSS1, 1.0f / W8_SCALE};
      pg8::gemm_phase<pg8::EpiResXB<true>, pg8::StaticOrder, true, false, true>((PG8_LAS unsigned char*)lds, g, So, E); xcd_barrier(bar); }
    { pg8::Gemm g{XB, WT_q1, T, D, D}; pg8::StaticOrder So; So.init(T, D, (int)gridDim.x, (int)blockIdx.x); EpiQSel E{RSS1, 1.0f / D, EPS, SKB + (size_t)8 * 2 * 128 * 64, EXP, GATE}; pg8::Unit uu;
      for (int i = 0; So.next(i, uu); ++i) { const OneUnit Su{uu}; pg8::gemm_phase<EpiQSel, OneUnit, true, true>((PG8_LAS unsigned char*)lds, g, Su, E); }
      xcd_barrier(bar); }
    { WV_SETUP
    for (int t = gw; t < T; t += NGW) peer_gather_token(XB, RSS1, UB + (size_t)16384 * (D / 2), VB + (size_t)16384 * (D / 2), EXP, GATE, XS, nullptr, nullptr, t, lane, wscr); }
}
}

extern "C" void kernel_launch(void* const* d_in, const int* in_sizes, int n_in, void* d_out, int out_size, void* d_ws, size_t ws_size, hipStream_t stream) {
    static int grid_blocks = 0;
    if (!grid_blocks) {
        int dev = 0, cus = 0;
        (void)hipGetDevice(&dev);
        (void)hipDeviceGetAttribute(&cus, hipDeviceAttributeMultiprocessorCount, dev);
        (void)hipFuncSetAttribute((const void*)fwd_megakernel, hipFuncAttributeMaxDynamicSharedMemorySize, LDS_BYTES);
        int per_cu = 0;
        if (hipOccupancyMaxActiveBlocksPerMultiprocessor(&per_cu, (const void*)fwd_megakernel, 512, (size_t)LDS_BYTES) != hipSuccess) per_cu = 1;
        (void)per_cu;
        grid_blocks = cus;
    }
    Params p{};
    for (int i = 0; i < 27; ++i) p.in[i] = (const float*)d_in[i];
    p.out = (float*)d_out; p.ws = (char*)d_ws;
    (void)hipMemsetAsync(d_ws, 0, 65536, stream);
    hipLaunchKernelGGL(fwd_megakernel, dim3(grid_blocks), dim3(512), LDS_BYTES, stream, p);
}
```

```cpp
#include <hip/hip_runtime.h>
#include <cstdio>
#include <math.h>
#include <stdint.h>

__device__ __forceinline__ int ltid() { int t = threadIdx.x; asm volatile("" : "+v"(t)); return t; }
namespace pg8 {
#define PG8_LAS __attribute__((address_space(3)))
typedef unsigned short bf16_t;
typedef short bf16x8 __attribute__((ext_vector_type(8)));
typedef float f32x4 __attribute__((ext_vector_type(4)));
typedef unsigned u32x4 __attribute__((ext_vector_type(4)));
constexpr int BM = 256, BK = 64, HALF = 128, HTB = HALF * BK * 2  , STAGE_BYTES = 8 * HTB, NXCD = 8, WGM = 4;

__host__ __device__ __forceinline__ int lds_byte(int r, int c) { const int st = (r >> 4) * 2 + (c >> 5), rr = r & 15, cc = c & 31, ob = rr * 64 + cc * 2; return st * 1024 + (ob ^ (((ob >> 9) & 1) << 5)); }
__host__ __device__ __forceinline__ void stage_rc(int b, int& R, int& C) { const int st = b / 1024, sb = b % 1024, swz = sb ^ (((sb >> 9) & 1) << 5); R = (st >> 1) * 16 + swz / 64; C = (st & 1) * 32 + (swz % 64) / 2; }
__host__ __device__ __forceinline__ int perm32(int rho) { const int n = rho >> 4, i = rho & 15; return 8 * (i >> 2) + 4 * n + (i & 3); }

struct Unit { int pm, pn; };
struct Gemm { const bf16_t* A; const bf16_t* Bt; int M, N, K; };

struct StaticOrder {
    int nM, nN, nwg, G, c;
    __host__ __device__ __forceinline__ void init(int M, int N, int G_, int c_) { nM = M / BM; nN = N / BM; nwg = nM * nN; G = G_; c = c_; }
    __host__ __device__ __forceinline__ bool next(int i, Unit& u) const {
        const long L = (long)i * G + c; if (L >= nwg) return false;
        int wgid = (int)L; { const int q = nwg / NXCD, r = nwg % NXCD, xcd = wgid % NXCD, off = wgid / NXCD; wgid = (xcd < r ? xcd * (q + 1) : r * (q + 1) + (xcd - r) * q) + off; }
        const int nig = WGM * nN, gid = wgid / nig, fm = gid * WGM, gsz = (nM - fm) < WGM ? (nM - fm) : WGM;
        u.pm = fm + ((wgid % nig) % gsz); u.pn = (wgid % nig) / gsz; return true;
    }
    __device__ __forceinline__ void a_ready(const Unit&) const {}
    __device__ __forceinline__ void done(const Unit&) const {}
};

__device__ __forceinline__ unsigned cvt_pk_bf16(float lo, float hi) { unsigned r; asm volatile("v_cvt_pk_bf16_f32 %0, %1, %2" : "=v"(r) : "v"(lo), "v"(hi)); return r; }
typedef float f32x2 __attribute__((ext_vector_type(2)));
__device__ __forceinline__ f32x2 gelu_pk(f32x2 v) {
    const f32x2 av = __builtin_elementwise_abs(v), d = av * 0.2316418882f + 1.0f;
    f32x2 t; t.x = __builtin_amdgcn_rcpf(d.x); t.y = __builtin_amdgcn_rcpf(d.y);
    f32x2 q = t * 0.5307027145f + (-0.7265760135f); q = q * t + 0.7107068705f; q = q * t + (-0.142248368f); q = q * t + 0.127414796f; q = q * t;
    const f32x2 s = (v * v) * (-0.72134752044f);
    f32x2 e; e.x = __builtin_amdgcn_exp2f(s.x); e.y = __builtin_amdgcn_exp2f(s.y);
    const f32x2 m = v * (q * e), r = v - m;
    f32x2 o; o.x = v.x < 0.f ? m.x : r.x; o.y = v.y < 0.f ? m.y : r.y; return o;
}

template <int ACT  > struct EpiBf16 {
    static constexpr bool PERM = true, AFTER_DRAIN = false, HEADMAP = false, F8_RECOMP = false; static_assert(ACT == 0 || ACT == 1, "EpiBf16: ACT is 0 (none) or 1 (gelu_pk)");
    bf16_t* O; int ldc; const float* bias; int split_cols; size_t split_stride; float scale0;
    __device__ __forceinline__ void operator()(const f32x4 (&acc)[2][2][4][2], const Unit& u, int wr, int wc, int fr, int fq) const {
        const int row0 = u.pm * BM + wr * 64 + fr; int colt = u.pn * BM; bf16_t* base = O;
        float sc = 1.f; if (split_cols) { const int t = colt / split_cols; base += (size_t)t * split_stride; colt -= t * split_cols; if (t == 0) sc = scale0; }
        const int col0 = colt + wc * 32 + 8 * fq, bcol0 = u.pn * BM + wc * 32 + 8 * fq;
        f32x4 bv[2][2];
#pragma unroll
        for (int bj = 0; bj < 2; ++bj)
#pragma unroll
            for (int n = 0; n < 2; ++n) bv[bj][n] = bias ? *(const f32x4*)(bias + bcol0 + bj * HALF + 4 * n) : (f32x4){0.f, 0.f, 0.f, 0.f};
#pragma unroll
        for (int ai = 0; ai < 2; ++ai)
#pragma unroll
            for (int m = 0; m < 4; ++m) { bf16_t* rowp = base + (size_t)(row0 + ai * HALF + m * 16) * ldc + col0;
#pragma unroll
                for (int bj = 0; bj < 2; ++bj) { f32x4 v0 = acc[ai][bj][m][0] + bv[bj][0], v1 = acc[ai][bj][m][1] + bv[bj][1];
                    if (ACT == 1) { f32x2 a = gelu_pk((f32x2){v0[0], v0[1]}), b = gelu_pk((f32x2){v0[2], v0[3]}), c = gelu_pk((f32x2){v1[0], v1[1]}), d = gelu_pk((f32x2){v1[2], v1[3]});
                        v0 = (f32x4){a.x, a.y, b.x, b.y}; v1 = (f32x4){c.x, c.y, d.x, d.y}; }
                    v0 = v0 * sc; v1 = v1 * sc; u32x4 w; w.x = cvt_pk_bf16(v0[0], v0[1]); w.y = cvt_pk_bf16(v0[2], v0[3]); w.z = cvt_pk_bf16(v1[0], v1[1]); w.w = cvt_pk_bf16(v1[2], v1[3]);
                    *(u32x4*)(rowp + bj * HALF) = w; } }
    }
};

template <bool RBF>
struct EpiResXB {
    static constexpr bool PERM = false, AFTER_DRAIN = false, HEADMAP = false, F8_RECOMP = true;
    const void* R; int ldc; bf16_t* XB; float* rowss; float oscale  ;
    __device__ __forceinline__ void operator()(const f32x4 (&acc)[2][2][4][2], const Unit& u, int wr, int wc, int fr, int fq) const {
        typedef __bf16 bf2v __attribute__((ext_vector_type(2))); typedef float f2v __attribute__((ext_vector_type(2))); typedef unsigned u2v __attribute__((ext_vector_type(2)));
        const int row0 = u.pm * BM + wr * 64 + fr, col0 = u.pn * BM + wc * 32 + 4 * fq;
#pragma unroll
        for (int ai = 0; ai < 2; ++ai)
#pragma unroll
            for (int m = 0; m < 4; ++m) { const int row = row0 + ai * HALF + m * 16; const size_t off = (size_t)row * ldc + col0; float ss = 0.f;
#pragma unroll
                for (int bj = 0; bj < 2; ++bj)
#pragma unroll
                    for (int n = 0; n < 2; ++n) { f32x4 rv;
                        if (RBF) { const u2v rw = *(const u2v*)((const bf16_t*)R + off + bj * HALF + n * 16);
                            rv[0] = __builtin_bit_cast(float, rw.x << 16); rv[1] = __builtin_bit_cast(float, rw.x & 0xffff0000u); rv[2] = __builtin_bit_cast(float, rw.y << 16); rv[3] = __builtin_bit_cast(float, rw.y & 0xffff0000u); }
                        else rv = *(const f32x4*)((const float*)R + off + bj * HALF + n * 16);
                        const f32x4 v = acc[ai][bj][m][n] * oscale + rv;
                        ss += (v[0] * v[0] + v[1] * v[1]) + (v[2] * v[2] + v[3] * v[3]);
                        f2v lo; lo.x = v[0]; lo.y = v[1]; f2v hi; hi.x = v[2]; hi.y = v[3]; u2v w; w.x = __builtin_bit_cast(unsigned, __builtin_convertvector(lo, bf2v)); w.y = __builtin_bit_cast(unsigned, __builtin_convertvector(hi, bf2v));
                        *(u2v*)(XB + off + bj * HALF + n * 16) = w; }
                ss += __shfl_xor(ss, 16); ss += __shfl_xor(ss, 32);
                if (fq == 0) rowss[(size_t)row * 16 + u.pn * 4 + wc] = ss; }
    }
};
struct EpiBf16Row {
    static constexpr bool PERM = true, AFTER_DRAIN = false, HEADMAP = false, F8_RECOMP = false;
    bf16_t* O; int ldc; const float* rowss; float invk, eps;
    __device__ __forceinline__ void operator()(const f32x4 (&acc)[2][2][4][2], const Unit& u, int wr, int wc, int fr, int fq) const {
        const int row0 = u.pm * BM + wr * 64 + fr; const int col0 = u.pn * BM + wc * 32 + 8 * fq;
#pragma unroll
        for (int ai = 0; ai < 2; ++ai)
#pragma unroll
            for (int m = 0; m < 4; ++m) { const int row = row0 + ai * HALF + m * 16; const f32x4* rp = (const f32x4*)(rowss + (size_t)row * 16); const f32x4 p0 = rp[0], p1 = rp[1], p2 = rp[2], p3 = rp[3];
                const float rs = (((p0[0] + p0[1]) + (p0[2] + p0[3])) + ((p1[0] + p1[1]) + (p1[2] + p1[3]))) + (((p2[0] + p2[1]) + (p2[2] + p2[3])) + ((p3[0] + p3[1]) + (p3[2] + p3[3])));
                const float sc = 1.0f / sqrtf(rs * invk + eps); bf16_t* rowp = O + (size_t)row * ldc + col0;
#pragma unroll
                for (int bj = 0; bj < 2; ++bj) { const f32x4 v0 = acc[ai][bj][m][0] * sc, v1 = acc[ai][bj][m][1] * sc;
                    u32x4 w; w.x = cvt_pk_bf16(v0[0], v0[1]); w.y = cvt_pk_bf16(v0[2], v0[3]); w.z = cvt_pk_bf16(v1[0], v1[1]); w.w = cvt_pk_bf16(v1[2], v1[3]);
                    *(u32x4*)(rowp + bj * HALF) = w; } }
    }
};
template <int MODE> struct EpiHead {
    static constexpr bool PERM = true, AFTER_DRAIN = false, HEADMAP = true, F8_RECOMP = false;
    bf16_t* O; int ldc; const float* na_gain; const float* dil_gain; const float* CS  ; int posmask; float eps; float oscale  ;
    __device__ __forceinline__ void operator()(const f32x4 (&acc)[2][2][4][2], const Unit& u, int wr, int wc, int fr, int fq) const {
        const int which = u.pn >> 1;
        bool do_norm, do_rope; float sc; const float* gain = na_gain;
        if (MODE == 0) { do_norm = false; do_rope = which < 2; sc = (which == 1) ? 0.125f : 1.0f; }
        else { do_norm = (which != 2 && which != 5); do_rope = (which == 3 || which == 4); sc = (which == 0 || which == 3) ? 0.125f : 1.0f;
               gain = (which < 2) ? na_gain + which * 64 : dil_gain + (which == 4 ? 64 : 0); }
        const int row0 = u.pm * BM + wr * 64 + fr, col0 = u.pn * BM + wc * 64 + 8 * fq;
        f32x4 gv[2][2];
#pragma unroll
        for (int bj = 0; bj < 2; ++bj)
#pragma unroll
            for (int n = 0; n < 2; ++n) { gv[bj][n] = (f32x4){sc, sc, sc, sc}; if (MODE == 1 && do_norm) gv[bj][n] = *(const f32x4*)(gain + 32 * bj + 8 * fq + 4 * n) * sc; }
#pragma unroll
        for (int ai = 0; ai < 2; ++ai)
#pragma unroll
            for (int m = 0; m < 4; ++m) { const int row = row0 + ai * HALF + m * 16;
                f32x4 v[2][2];
#pragma unroll
                for (int bj = 0; bj < 2; ++bj)
#pragma unroll
                    for (int n = 0; n < 2; ++n) v[bj][n] = acc[ai][bj][m][n] * oscale;
                float r = 1.0f;
                if (MODE == 1 && do_norm) { float ss = 0.f;
#pragma unroll
                    for (int bj = 0; bj < 2; ++bj)
#pragma unroll
                        for (int n = 0; n < 2; ++n) ss += (v[bj][n][0] * v[bj][n][0] + v[bj][n][1] * v[bj][n][1]) + (v[bj][n][2] * v[bj][n][2] + v[bj][n][3] * v[bj][n][3]);
                    ss += __shfl_xor(ss, 16); ss += __shfl_xor(ss, 32); r = 1.0f / sqrtf(ss * (1.0f / 64.0f) + eps); }
#pragma unroll
                for (int bj = 0; bj < 2; ++bj)
#pragma unroll
                    for (int n = 0; n < 2; ++n) v[bj][n] = v[bj][n] * gv[bj][n] * r;
                if (do_rope) { const f32x4* cp = (const f32x4*)(CS + ((size_t)(row & posmask) * 32 + 8 * fq) * 2);
#pragma unroll
                    for (int n = 0; n < 2; ++n) { const f32x4 c01 = cp[2 * n], c23 = cp[2 * n + 1]; const f32x4 a = v[0][n], b = v[1][n];
                        v[0][n][0] = a[0] * c01[0] - b[0] * c01[1]; v[1][n][0] = b[0] * c01[0] + a[0] * c01[1];
                        v[0][n][1] = a[1] * c01[2] - b[1] * c01[3]; v[1][n][1] = b[1] * c01[2] + a[1] * c01[3];
                        v[0][n][2] = a[2] * c23[0] - b[2] * c23[1]; v[1][n][2] = b[2] * c23[0] + a[2] * c23[1];
                        v[0][n][3] = a[3] * c23[2] - b[3] * c23[3]; v[1][n][3] = b[3] * c23[2] + a[3] * c23[3]; } }
                bf16_t* rowp = O + (size_t)row * ldc + col0;
#pragma unroll
                for (int bj = 0; bj < 2; ++bj) { u32x4 w; w.x = cvt_pk_bf16(v[bj][0][0], v[bj][0][1]); w.y = cvt_pk_bf16(v[bj][0][2], v[bj][0][3]); w.z = cvt_pk_bf16(v[bj][1][0], v[bj][1][1]); w.w = cvt_pk_bf16(v[bj][1][2], v[bj][1][3]);
                    *(u32x4*)(rowp + 32 * bj) = w; } }
    }
};
struct EpiF32R {
    static constexpr bool PERM = false, AFTER_DRAIN = false, HEADMAP = false, F8_RECOMP = false;
    float* C; int ldc; const float* R;
    __device__ __forceinline__ void operator()(const f32x4 (&acc)[2][2][4][2], const Unit& u, int wr, int wc, int fr, int fq) const {
        const int row0 = u.pm * BM + wr * 64 + fr, col0 = u.pn * BM + wc * 32 + 4 * fq;
#pragma unroll
        for (int ai = 0; ai < 2; ++ai)
#pragma unroll
            for (int m = 0; m < 4; ++m) { const size_t off = (size_t)(row0 + ai * HALF + m * 16) * ldc + col0;
#pragma unroll
                for (int bj = 0; bj < 2; ++bj)
#pragma unroll
                    for (int n = 0; n < 2; ++n) { f32x4 v = acc[ai][bj][m][n]; if (R) v = v + *(const f32x4*)(R + off + bj * HALF + n * 16); *(f32x4*)(C + off + bj * HALF + n * 16) = v; } }
    }
};

template <class Epi, class Sched, bool ALIGN_EPI = false, bool SP2 = false, bool F8 = false>
__device__ __forceinline__ void gemm_phase(PG8_LAS unsigned char* lds, const Gemm g, const Sched& S, const Epi& E) {
    const int tid = ltid(), wid = __builtin_amdgcn_readfirstlane(tid >> 6), lane = tid & 63, wr = wid >> 2, wc = wid & 3, fr = lane & 15, fq = lane >> 4;
    const int K = g.K, rowb = F8 ? K : 2 * K, nt = rowb / (BK * 2);
    unsigned voffA[2], voffB[2];
#pragma unroll
    for (int i = 0; i < 2; ++i) { int R, C; stage_rc(tid * 16 + i * 8192, R, C); const int Rb = Epi::HEADMAP ? (64 * (R >> 5) + perm32(R & 31)) : (Epi::PERM ? ((R & ~31) + perm32(R & 31)) : R);
        voffA[i] = (unsigned)(R * rowb + 2 * C); voffB[i] = (unsigned)(Rb * rowb + 2 * C); }
    auto voffA_of = [&](int t_, int i_) -> unsigned { asm volatile("" : "+v"(t_)); int R, C; stage_rc(t_ * 16 + i_ * 8192, R, C); return (unsigned)(R * rowb + 2 * C); };
    auto voffB_of = [&](int t_, int i_) -> unsigned { asm volatile("" : "+v"(t_)); int R, C; stage_rc(t_ * 16 + i_ * 8192, R, C); const int Rb = Epi::HEADMAP ? (64 * (R >> 5) + perm32(R & 31)) : (Epi::PERM ? ((R & ~31) + perm32(R & 31)) : R); return (unsigned)(Rb * rowb + 2 * C); };
    (void)voffA_of; (void)voffB_of;
    const size_t kstep = (size_t)(BK * 2);
    const size_t hstep = (size_t)HALF * rowb;
    const size_t tstep = 2 * hstep;
    const size_t bstep = Epi::HEADMAP ? (size_t)32 * rowb : hstep;
    const unsigned ldsw = (unsigned)wid * 1024u;
    const int aoff = F8 ? lds_byte(wr * 64 + fr, fq * 16) : lds_byte(wr * 64 + fr, fq * 8), boff = F8 ? lds_byte(wc * 32 + fr, fq * 16) : lds_byte(wc * 32 + fr, fq * 8);
    constexpr int akst = F8 ? 16 : 1024, bkst = F8 ? 16 : 1024;
#define PG8_SA(b, h) (((b) * 2 + (h)) * HTB)
#define PG8_SB(b, h) ((4 + (b) * 2 + (h)) * HTB)
#define PG8_STAGE(bufoff, gbase, voff) do { _Pragma("unroll") for (int _i = 0; _i < 2; ++_i) \
        { unsigned vo_ = (voff)[_i]; if constexpr (F8 && Epi::F8_RECOMP) vo_ = voff##_of(tid, _i); else if constexpr (F8) asm volatile("" : "+v"(vo_));        \
        __builtin_amdgcn_global_load_lds((const unsigned*)((const char*)(gbase) + vo_), (PG8_LAS unsigned*)(lds + (bufoff) + ldsw + _i * 8192), 16, 0, 0); } } while (0)
#define PG8_LDA(dst, b, h) do { _Pragma("unroll") for (int m = 0; m < 4; ++m) { if constexpr (F8) { const PG8_LAS unsigned char* p_ = lds + PG8_SA(b, h) + aoff + m * 2048; \
        dst##8[m] = *(const PG8_LAS v8i_*)p_; } \
        else { _Pragma("unroll") for (int k = 0; k < 2; ++k) dst[m][k] = *(const PG8_LAS bf16x8*)(lds + PG8_SA(b, h) + aoff + m * 2048 + k * akst); } } } while (0)
#define PG8_LDB(dst, b, h) do { _Pragma("unroll") for (int n = 0; n < 2; ++n) { if constexpr (F8) { const PG8_LAS unsigned char* p_ = lds + PG8_SB(b, h) + boff + n * 2048; \
        dst##8[n] = *(const PG8_LAS v8i_*)p_; } \
        else { _Pragma("unroll") for (int k = 0; k < 2; ++k) dst[n][k] = *(const PG8_LAS bf16x8*)(lds + PG8_SB(b, h) + boff + n * 2048 + k * bkst); } } } while (0)
#define PG8_MMA(ai, bj, At, Bt) do { __builtin_amdgcn_s_setprio(1); _Pragma("unroll") for (int m = 0; m < 4; ++m) _Pragma("unroll") for (int n = 0; n < 2; ++n) { \
        if constexpr (F8) acc[ai][bj][m][n] = __builtin_amdgcn_mfma_scale_f32_16x16x128_f8f6f4(Bt##8[n], At##8[m], acc[ai][bj][m][n], 0, 0, 0, 0, 0, 0); \
        else { _Pragma("unroll") for (int k = 0; k < 2; ++k) acc[ai][bj][m][n] = __builtin_amdgcn_mfma_f32_16x16x32_bf16(Bt[n][k], At[m][k], acc[ai][bj][m][n], 0, 0, 0); } } \
        __builtin_amdgcn_s_setprio(0); } while (0)
#define PG8_WAIT_V(n) asm volatile("s_waitcnt vmcnt(" #n ")" ::: "memory")
#define PG8_WAIT_L(n) asm volatile("s_waitcnt lgkmcnt(" #n ")" ::: "memory")
#define PG8_BAR __builtin_amdgcn_s_barrier()
#define PG8_SCHED __builtin_amdgcn_sched_barrier(0)
    Unit cur, nxt; int ui = 0;
    if (!S.next(0, cur)) return;
    f32x4 acc[2][2][4][2];
#pragma unroll
    for (int a = 0; a < 2; ++a)
#pragma unroll
        for (int b = 0; b < 2; ++b)
#pragma unroll
            for (int m = 0; m < 4; ++m)
#pragma unroll
                for (int n = 0; n < 2; ++n) acc[a][b][m][n] = (f32x4){0.f, 0.f, 0.f, 0.f};
    bf16x8 At[4][2], B0[2][2], B1[2][2];
    typedef int v4i_ __attribute__((ext_vector_type(4))); typedef int v8i_ __attribute__((ext_vector_type(8)));
    v8i_ At8[4], B08[2], B18[2];
    (void)At; (void)B0; (void)B1; (void)At8; (void)B08; (void)B18;
    const char* cA = (const char*)g.A + (size_t)cur.pm * tstep; const char* cB = (const char*)g.Bt + (size_t)cur.pn * tstep;
    S.a_ready(cur);
    if constexpr (SP2) {
        PG8_STAGE(PG8_SB(0, 0), cB, voffB); PG8_STAGE(PG8_SB(0, 1), cB + bstep, voffB); PG8_STAGE(PG8_SA(0, 0), cA, voffA); PG8_STAGE(PG8_SA(0, 1), cA + hstep, voffA);
        if (wr == 1) PG8_BAR;
        PG8_WAIT_V(2); PG8_BAR;
        PG8_STAGE(PG8_SB(1, 0), cB + kstep, voffB); PG8_STAGE(PG8_SA(1, 0), cA + kstep, voffA); PG8_STAGE(PG8_SB(1, 1), cB + bstep + kstep, voffB);
        PG8_WAIT_V(6); PG8_BAR;
    } else {
        PG8_STAGE(PG8_SB(0, 0), cB, voffB); PG8_STAGE(PG8_SA(0, 0), cA, voffA); PG8_STAGE(PG8_SB(0, 1), cB + bstep, voffB); PG8_STAGE(PG8_SA(0, 1), cA + hstep, voffA);
        if (wr == 1) PG8_BAR;
        PG8_WAIT_V(4); PG8_BAR;
        PG8_STAGE(PG8_SB(1, 0), cB + kstep, voffB); PG8_STAGE(PG8_SA(1, 0), cA + kstep, voffA); PG8_STAGE(PG8_SB(1, 1), cB + bstep + kstep, voffB);
        PG8_WAIT_V(6); PG8_BAR;
    }
    for (;;) {
        const bool has_next = S.next(ui + 1, nxt);
        const char* nA = has_next ? (const char*)g.A + (size_t)nxt.pm * tstep : cA; const char* nB = has_next ? (const char*)g.Bt + (size_t)nxt.pn * tstep : cB;
#pragma unroll 1
        for (int t = 0; t < nt; t += 2) {
            const bool last = (t == nt - 2);
            const char* a1 = cA + (size_t)(t + 1) * kstep;
            const char* a2 = last ? nA : cA + (size_t)(t + 2) * kstep; const char* b2 = last ? nB : cB + (size_t)(t + 2) * kstep;
            const char* a3 = a2 + kstep; const char* b3 = b2 + kstep;
            if (last && has_next) S.a_ready(nxt);
            if constexpr (SP2) {
            PG8_LDB(B0, 0, 0); PG8_LDB(B1, 0, 1); PG8_SCHED; PG8_LDA(At, 0, 0); PG8_STAGE(PG8_SA(1, 1), a1 + hstep, voffA);
            PG8_WAIT_V(8); PG8_WAIT_L(0); PG8_BAR; PG8_MMA(0, 0, At, B0); PG8_MMA(0, 1, At, B1); PG8_BAR; PG8_SCHED;
            PG8_LDA(At, 0, 1); PG8_STAGE(PG8_SB(0, 0), b2, voffB); PG8_STAGE(PG8_SB(0, 1), b2 + bstep, voffB); PG8_STAGE(PG8_SA(0, 0), a2, voffA);
            PG8_WAIT_V(8); PG8_WAIT_L(0); PG8_BAR; PG8_MMA(1, 0, At, B0); PG8_MMA(1, 1, At, B1); PG8_BAR; PG8_SCHED;
            PG8_LDB(B0, 1, 0); PG8_LDB(B1, 1, 1); PG8_SCHED; PG8_LDA(At, 1, 0); PG8_STAGE(PG8_SA(0, 1), a2 + hstep, voffA);
            PG8_WAIT_V(8); PG8_WAIT_L(0); PG8_BAR; PG8_MMA(0, 0, At, B0); PG8_MMA(0, 1, At, B1); PG8_BAR; PG8_SCHED;
            PG8_LDA(At, 1, 1); PG8_STAGE(PG8_SB(1, 0), b3, voffB); PG8_STAGE(PG8_SB(1, 1), b3 + bstep, voffB); PG8_STAGE(PG8_SA(1, 0), a3, voffA);
            PG8_WAIT_V(8); PG8_WAIT_L(0); PG8_BAR; PG8_MMA(1, 0, At, B0); PG8_MMA(1, 1, At, B1); PG8_BAR; PG8_SCHED;
            } else {
            PG8_LDB(B0, 0, 0); PG8_SCHED; PG8_LDA(At, 0, 0); PG8_STAGE(PG8_SA(1, 1), a1 + hstep, voffA);
            PG8_WAIT_L(8); PG8_BAR; PG8_WAIT_L(0); PG8_MMA(0, 0, At, B0); PG8_BAR; PG8_SCHED;
            PG8_LDB(B1, 0, 1); PG8_STAGE(PG8_SB(0, 0), b2, voffB);
            PG8_BAR; PG8_WAIT_L(0); PG8_MMA(0, 1, At, B1); PG8_BAR;
            PG8_LDA(At, 0, 1); PG8_STAGE(PG8_SA(0, 0), a2, voffA);
            PG8_BAR; PG8_WAIT_L(0); PG8_MMA(1, 0, At, B0); PG8_BAR; PG8_SCHED;
            PG8_STAGE(PG8_SB(0, 1), b2 + bstep, voffB);
            PG8_WAIT_V(6); PG8_BAR; PG8_MMA(1, 1, At, B1); PG8_BAR;
            PG8_LDB(B0, 1, 0); PG8_SCHED; PG8_LDA(At, 1, 0); PG8_STAGE(PG8_SA(0, 1), a2 + hstep, voffA);
            PG8_WAIT_L(8); PG8_BAR; PG8_WAIT_L(0); PG8_MMA(0, 0, At, B0); PG8_BAR; PG8_SCHED;
            PG8_LDB(B1, 1, 1); PG8_STAGE(PG8_SB(1, 0), b3, voffB);
            PG8_BAR; PG8_WAIT_L(0); PG8_MMA(0, 1, At, B1); PG8_BAR;
            PG8_LDA(At, 1, 1); PG8_STAGE(PG8_SA(1, 0), a3, voffA);
            PG8_BAR; PG8_WAIT_L(0); PG8_MMA(1, 0, At, B0); PG8_BAR; PG8_SCHED;
            PG8_STAGE(PG8_SB(1, 1), b3 + bstep, voffB);
            PG8_WAIT_V(6); PG8_BAR; PG8_MMA(1, 1, At, B1); PG8_BAR;
            }
        }
        if constexpr (ALIGN_EPI) { if (wr == 0) PG8_BAR; }
        if constexpr (!Epi::AFTER_DRAIN) { const int l2_ = ltid() & 63; E(acc, cur, wr, wc, l2_ & 15, l2_ >> 4); S.done(cur); }
        if (!has_next) break;
#pragma unroll
        for (int a = 0; a < 2; ++a)
#pragma unroll
            for (int b = 0; b < 2; ++b)
#pragma unroll
                for (int m = 0; m < 4; ++m)
#pragma unroll
                    for (int n = 0; n < 2; ++n) acc[a][b][m][n] = (f32x4){0.f, 0.f, 0.f, 0.f};
        cur = nxt; cA = nA; cB = nB; ++ui;
        if constexpr (ALIGN_EPI) { if (wr == 1) PG8_BAR; }
    }
    PG8_WAIT_V(0);
    if constexpr (!ALIGN_EPI) { if (wr == 0) PG8_BAR; }
    PG8_BAR;
    if constexpr (Epi::AFTER_DRAIN) { E.fused(acc, cur, wr, wc, fr, fq, lds, wid, lane); S.done(cur); }
#undef PG8_SA
#undef PG8_SB
#undef PG8_STAGE
#undef PG8_LDA
#undef PG8_LDB
#undef PG8_MMA
#undef PG8_WAIT_V
#undef PG8_WAIT_L
#undef PG8_BAR
#undef PG8_SCHED
}
}

namespace {
constexpr int NB = 8, S = 2048, D = 1024, T = NB * S;
constexpr int EVEN_IN = 3584, ODD_IN = 3072, HY_IN = 1536, HYC = 512;
constexpr float EPS = 1e-6f;
#define LAS __attribute__((address_space(3)))
typedef unsigned short bf16;
typedef unsigned v4u __attribute__((ext_vector_type(4)));
constexpr int LDS_BYTES = 147456;
__device__ __forceinline__ unsigned f2bf(float f) { unsigned u = __builtin_bit_cast(unsigned, f); return (u + 0x7fffu + ((u >> 16) & 1u)) >> 16; }
typedef __bf16 bf2_t_ __attribute__((ext_vector_type(2)));
typedef float f32x2_t_ __attribute__((ext_vector_type(2)));
__device__ __forceinline__ unsigned pkbf(float lo, float hi) { f32x2_t_ v; v.x = lo; v.y = hi; return __builtin_bit_cast(unsigned, __builtin_convertvector(v, bf2_t_)); }
__device__ __forceinline__ unsigned pk2(float lo, float hi) { return pkbf(lo, hi); }
__device__ __forceinline__ float bf2f(unsigned short b) { return __builtin_bit_cast(float, (unsigned)b << 16); }
__device__ __forceinline__ float bflo(unsigned w) { return __builtin_bit_cast(float, w << 16); }
__device__ __forceinline__ float bfhi(unsigned w) { return __builtin_bit_cast(float, w & 0xffff0000u); }
__device__ __forceinline__ float4 ld4bf(const unsigned short* p) { const uint2 w = *(const uint2*)p; return make_float4(bflo(w.x), bfhi(w.x), bflo(w.y), bfhi(w.y)); }

constexpr float W8_SCALE = 32.0f;
__device__ __forceinline__ unsigned pk4_fp8(float a, float b, float c, float d) { int w = 0; w = __builtin_amdgcn_cvt_pk_fp8_f32(a, b, w, false); w = __builtin_amdgcn_cvt_pk_fp8_f32(c, d, w, true); return (unsigned)w; }
__device__ __forceinline__ float wave_sum(float v) {
#pragma unroll
    for (int o = 1; o < 64; o <<= 1) v += __shfl_xor(v, o);
    return v;
}

__device__ __forceinline__ void k_rmsnorm(int vb, int tid, const float* x, const float* __restrict__ gain, float* y, unsigned short* yb) {
    const int row = vb * 4 + (tid >> 6), lane = tid & 63;
    const float4* xr = (const float4*)(x + (size_t)row * D);
    const float4* g4 = (const float4*)gain;
    float4 v[4]; float s = 0.f;
#pragma unroll
    for (int j = 0; j < 4; ++j) { v[j] = xr[lane + 64 * j]; s += v[j].x * v[j].x + v[j].y * v[j].y + v[j].z * v[j].z + v[j].w * v[j].w; }
    s = wave_sum(s);
    const float r = 1.0f / sqrtf(s * (1.0f / D) + EPS);
#pragma unroll
    for (int j = 0; j < 4; ++j) { const float4 g = g4[lane + 64 * j]; float4 o; o.x = v[j].x * r * g.x; o.y = v[j].y * r * g.y; o.z = v[j].z * r * g.z; o.w = v[j].w * r * g.w;
        if (y) ((float4*)(y + (size_t)row * D))[lane + 64 * j] = o;
        if (yb) { uint2 w; w.x = pk2(o.x, o.y); w.y = pk2(o.z, o.w); ((uint2*)(yb + (size_t)row * D))[lane + 64 * j] = w; } }
}


typedef short bf16x8 __attribute__((ext_vector_type(8)));
typedef float f32x16 __attribute__((ext_vector_type(16)));
typedef unsigned u32x4 __attribute__((ext_vector_type(4)));
typedef unsigned u32x2 __attribute__((ext_vector_type(2)));
typedef __bf16 bf16x2_t __attribute__((ext_vector_type(2)));
typedef float f32x2_t __attribute__((ext_vector_type(2)));
__device__ __forceinline__ float max3f(float a, float b, float c) { return fmaxf(fmaxf(a, b), c); }
__device__ __forceinline__ int f2sort(float f) { const int b = __float_as_int(f); return b ^ ((b >> 31) & 0x7fffffff); }
__device__ __forceinline__ float sort2f(int k) { return __int_as_float(k ^ ((k >> 31) & 0x7fffffff)); }
__device__ __forceinline__ void ce_desc(int& a, int& b) { const int hi = a > b ? a : b, lo = a > b ? b : a; a = hi; b = lo; }
template <int N> __device__ __forceinline__ void bitonic_sort_desc(int (&a)[N]) {
#pragma unroll
    for (int k = 2; k <= N; k <<= 1)
#pragma unroll
        for (int j = k >> 1; j >= 1; j >>= 1)
#pragma unroll
            for (int i = 0; i < N; ++i) { const int l = i ^ j; if (l > i) { if ((i & k) == 0) ce_desc(a[i], a[l]); else ce_desc(a[l], a[i]); } }
}
__device__ __forceinline__ void ce_desc(float& a, float& b) { const float hi = __builtin_fmaxf(a, b), lo = __builtin_fminf(a, b); a = hi; b = lo; }
template <int N> __device__ __forceinline__ void bitonic_sort_desc(float (&a)[N]) {
#pragma unroll
    for (int k = 2; k <= N; k <<= 1)
#pragma unroll
        for (int j = k >> 1; j >= 1; j >>= 1)
#pragma unroll
            for (int i = 0; i < N; ++i) { const int l = i ^ j; if (l > i) { if ((i & k) == 0) ce_desc(a[i], a[l]); else ce_desc(a[l], a[i]); } }
}
__device__ __forceinline__ void top16_merge(float (&a)[16], const float (&b)[16]) {
#pragma unroll
    for (int i = 0; i < 16; ++i) a[i] = __builtin_fmaxf(a[i], b[15 - i]);
#pragma unroll
    for (int j = 8; j >= 1; j >>= 1)
#pragma unroll
        for (int i = 0; i < 16; ++i) { const int l = i ^ j; if (l > i) ce_desc(a[i], a[l]); }
}
__device__ __forceinline__ void sort16_desc(float (&a)[16]) {
    ce_desc(a[0], a[13]); ce_desc(a[1], a[12]); ce_desc(a[2], a[15]); ce_desc(a[3], a[14]); ce_desc(a[4], a[8]); ce_desc(a[5], a[6]); ce_desc(a[7], a[11]); ce_desc(a[9], a[10]);
    ce_desc(a[0], a[5]); ce_desc(a[1], a[7]); ce_desc(a[2], a[9]); ce_desc(a[3], a[4]); ce_desc(a[6], a[13]); ce_desc(a[8], a[14]); ce_desc(a[10], a[15]); ce_desc(a[11], a[12]);
    ce_desc(a[0], a[1]); ce_desc(a[2], a[3]); ce_desc(a[4], a[5]); ce_desc(a[6], a[8]); ce_desc(a[7], a[9]); ce_desc(a[10], a[11]); ce_desc(a[12], a[13]); ce_desc(a[14], a[15]);
    ce_desc(a[0], a[2]); ce_desc(a[1], a[3]); ce_desc(a[4], a[10]); ce_desc(a[5], a[11]); ce_desc(a[6], a[7]); ce_desc(a[8], a[9]); ce_desc(a[12], a[14]); ce_desc(a[13], a[15]);
    ce_desc(a[1], a[2]); ce_desc(a[3], a[12]); ce_desc(a[4], a[6]); ce_desc(a[5], a[7]); ce_desc(a[8], a[10]); ce_desc(a[9], a[11]); ce_desc(a[13], a[14]);
    ce_desc(a[1], a[4]); ce_desc(a[2], a[6]); ce_desc(a[5], a[8]); ce_desc(a[7], a[10]); ce_desc(a[9], a[13]); ce_desc(a[11], a[14]);
    ce_desc(a[2], a[4]); ce_desc(a[3], a[6]); ce_desc(a[9], a[12]); ce_desc(a[11], a[13]);
    ce_desc(a[3], a[5]); ce_desc(a[6], a[8]); ce_desc(a[7], a[9]); ce_desc(a[10], a[12]);
    ce_desc(a[3], a[4]); ce_desc(a[5], a[6]); ce_desc(a[7], a[8]); ce_desc(a[9], a[10]); ce_desc(a[11], a[12]);
    ce_desc(a[6], a[7]); ce_desc(a[8], a[9]);
}
__device__ __forceinline__ void top16_merge(int (&a)[16], const int (&b)[16]) {
#pragma unroll
    for (int i = 0; i < 16; ++i) a[i] = a[i] > b[15 - i] ? a[i] : b[15 - i];
#pragma unroll
    for (int j = 8; j >= 1; j >>= 1)
#pragma unroll
        for (int i = 0; i < 16; ++i) { const int l = i ^ j; if (l > i) ce_desc(a[i], a[l]); }
}
template <bool QLDS>
__device__ __forceinline__ void peer_select_unit(const unsigned short* Qb, const unsigned short* SKB, int tt, int h, int lane, LAS float* scr, unsigned short* EXPo, float* GATEo) {
    const int r32 = lane & 31, hh = lane >> 5;
    const int t = tt * 32 + r32;
    bf16x8 qpre[2][4];
    if (QLDS) {
#pragma unroll
        for (int p = 0; p < 2; ++p)
#pragma unroll
            for (int ks = 0; ks < 4; ++ks) qpre[p][ks] = *(const LAS bf16x8*)((const LAS unsigned char*)scr + r32 * 256 + (((p * 8 + ks * 2 + hh) ^ (r32 & 15)) * 16));
    }
#pragma unroll 1
    for (int p = 0; p < 2; ++p) {
        f32x16 acc[4];
#pragma unroll
        for (int kt = 0; kt < 4; ++kt)
#pragma unroll
            for (int i = 0; i < 16; ++i) acc[kt][i] = 0.f;
        bf16x8 qf[4];
#pragma unroll
        for (int ks = 0; ks < 4; ++ks) { if (QLDS) qf[ks] = p ? qpre[1][ks] : qpre[0][ks]; else qf[ks] = *(const bf16x8*)(Qb + (size_t)t * D + h * 128 + p * 64 + ks * 16 + hh * 8); }
#pragma unroll
        for (int kt = 0; kt < 4; ++kt)
#pragma unroll
            for (int ks = 0; ks < 4; ++ks) {
                const bf16x8 kf = *(const bf16x8*)(SKB + ((size_t)((h * 2 + p) * 128 + kt * 32 + r32)) * 64 + ks * 16 + hh * 8);
                acc[kt] = __builtin_amdgcn_mfma_f32_32x32x16_bf16(kf, qf[ks], acc[kt], 0, 0, 0);
            }
        float g[4][16];
#pragma unroll
        for (int kt = 0; kt < 4; ++kt)
#pragma unroll
            for (int i = 0; i < 16; ++i) {
                const unsigned key = (unsigned)(kt * 32 + (i & 3) + 8 * (i >> 2)) + 4u * (unsigned)hh;
                const float av = acc[kt][i];
                g[kt][i] = __uint_as_float((__float_as_uint(av) & ~127u) | key);
            }
#pragma unroll
        for (int kt = 0; kt < 4; ++kt) sort16_desc(g[kt]);
        top16_merge(g[0], g[1]); top16_merge(g[2], g[3]); top16_merge(g[0], g[2]);
        float pb[16];
#pragma unroll
        for (int i = 0; i < 16; ++i) pb[i] = __shfl_xor(g[0][i], 32);
        top16_merge(g[0], pb);
#pragma unroll
        for (int i = 0; i < 16; ++i) scr[(p * 16 + i) * 64 + lane] = g[0][i];
    }
    float ta[16], tb[16];
#pragma unroll
    for (int i = 0; i < 16; ++i) { ta[i] = scr[i * 64 + lane]; tb[i] = scr[(16 + i) * 64 + lane]; }
    float cand[32];
#pragma unroll
    for (int i = 25; i < 32; ++i) cand[i] = -__builtin_inff();
    {
        int c = 0;
#pragma unroll
        for (int a = 0; a < 16; ++a)
#pragma unroll
            for (int bq = 0; bq < 16; ++bq) {
                if ((a + 1) * (bq + 1) <= 16) {
                    const float sum = ta[a] + tb[bq];
                    const float packed = __uint_as_float((__float_as_uint(sum) & ~255u) | (unsigned)(a * 16 + bq));
                    if ((c & 1) == 0) cand[c >> 1] = packed;
                    else cand[c >> 1] = hh ? packed : cand[c >> 1];
                    ++c;
                }
            }
    }
    bitonic_sort_desc(cand);
    float top[16], pb2[16];
#pragma unroll
    for (int i = 0; i < 16; ++i) { top[i] = cand[i]; pb2[i] = __shfl_xor(cand[i], 32); }
    top16_merge(top, pb2);
    if (hh == 0) {
        float gs[16]; unsigned es[16];
#pragma unroll
        for (int i = 0; i < 16; ++i) {
            const float gv = top[i]; const unsigned bits = __float_as_uint(gv);
            const unsigned ka = __float_as_uint(scr[((bits >> 4) & 15u) * 64 + lane]) & 127u, kb = __float_as_uint(scr[(16 + (bits & 15u)) * 64 + lane]) & 127u;
            gs[i] = gv; es[i] = ka * 128u + kb;
        }
        float sm = 0.f; const float g0 = gs[0];
#pragma unroll
        for (int i = 0; i < 16; ++i) { gs[i] = __expf(gs[i] - g0); sm += gs[i]; }
        const float inv = 1.0f / sm;
        u32x4* eo = (u32x4*)(EXPo + (size_t)t * 128 + h * 16);
        u32x4 w0, w1;
        w0.x = es[0] | (es[1] << 16); w0.y = es[2] | (es[3] << 16); w0.z = es[4] | (es[5] << 16); w0.w = es[6] | (es[7] << 16);
        w1.x = es[8] | (es[9] << 16); w1.y = es[10] | (es[11] << 16); w1.z = es[12] | (es[13] << 16); w1.w = es[14] | (es[15] << 16);
        eo[0] = w0; eo[1] = w1;
        float4* go = (float4*)(GATEo + (size_t)t * 128 + h * 16);
#pragma unroll
        for (int i = 0; i < 4; ++i) go[i] = make_float4(gs[4 * i] * inv, gs[4 * i + 1] * inv, gs[4 * i + 2] * inv, gs[4 * i + 3] * inv);
    }
}

struct EpiQSel {
    static constexpr bool PERM = true, AFTER_DRAIN = true, HEADMAP = false, F8_RECOMP = true;
    const float* rowss; float invk, eps; const unsigned short* SKB; unsigned short* EXPo; float* GATEo;
    __device__ __forceinline__ void operator()(const pg8::f32x4 (&)[2][2][4][2], const pg8::Unit&, int, int, int, int) const {}
    __device__ __forceinline__ void fused(const pg8::f32x4 (&acc)[2][2][4][2], const pg8::Unit& u, int wr, int wc, int fr, int fq, PG8_LAS unsigned char* lds, int wid, int lane) const {
#pragma unroll
        for (int ai = 0; ai < 2; ++ai)
#pragma unroll
            for (int m = 0; m < 4; ++m) { const int row = ai * 128 + wr * 64 + m * 16 + fr; const pg8::f32x4* rp = (const pg8::f32x4*)(rowss + (size_t)(u.pm * 256 + row) * 16); const pg8::f32x4 p0 = rp[0], p1 = rp[1], p2 = rp[2], p3 = rp[3];
                const float rs = (((p0[0] + p0[1]) + (p0[2] + p0[3])) + ((p1[0] + p1[1]) + (p1[2] + p1[3]))) + (((p2[0] + p2[1]) + (p2[2] + p2[3])) + ((p3[0] + p3[1]) + (p3[2] + p3[3])));
                const float sc = 1.0f / sqrtf(rs * invk + eps); const int rr = row & 31;
#pragma unroll
                for (int bj = 0; bj < 2; ++bj) { const pg8::f32x4 v0 = acc[ai][bj][m][0] * sc, v1 = acc[ai][bj][m][1] * sc;
                    pg8::u32x4 w; w.x = pg8::cvt_pk_bf16(v0[0], v0[1]); w.y = pg8::cvt_pk_bf16(v0[2], v0[3]); w.z = pg8::cvt_pk_bf16(v1[0], v1[1]); w.w = pg8::cvt_pk_bf16(v1[2], v1[3]);
                    *(PG8_LAS pg8::u32x4*)(lds + (bj * 8 + (row >> 5)) * 8192 + rr * 256 + (((4 * wc + fq) ^ (rr & 15)) * 16)) = w; } }
        __syncthreads();
#pragma unroll 1
        for (int hs = 0; hs < 2; ++hs) peer_select_unit<true>(nullptr, SKB, u.pm * 8 + wid, 2 * u.pn + hs, lane, (LAS float*)(lds + (hs * 8 + wid) * 8192), EXPo, GATEo);
        __syncthreads();
    }
};
struct OneUnit {
    pg8::Unit u0;
    __device__ __forceinline__ bool next(int k, pg8::Unit& u) const { if (k != 0) return false; u = u0; return true; }
    __device__ __forceinline__ void a_ready(const pg8::Unit&) const {}
    __device__ __forceinline__ void done(const pg8::Unit&) const {}
};

struct RetOrder {
    int c;
    __device__ __forceinline__ bool next(int i, pg8::Unit& u) const {
        if (i >= 2) return false;
        const int k = (c & 127) >> 3;
        u.pm = (c & 7) * 8 + (k >> 1);
        u.pn = (c >= 128) ? (i == 0 ? 2 : 4) + (k & 1) : (i == 0 ? 0 : 6) + (k & 1);
        return true; }
    __device__ __forceinline__ void a_ready(const pg8::Unit&) const {}
    __device__ __forceinline__ void done(const pg8::Unit&) const {}
};

constexpr float U8_SCALE = 45.0f, V8_SCALE = 4.0f;
__device__ __forceinline__ float dot2bf(unsigned a, bf16x2_t b, float c) { return __builtin_amdgcn_fdot2_f32_bf16(__builtin_bit_cast(bf16x2_t, a), b, c, false); }
__device__ __forceinline__ unsigned pk8_fp4(float4 a, float4 b, float sc) {
    unsigned w = 0u;
    w = __builtin_amdgcn_cvt_scalef32_pk_fp4_f32(w, a.x * sc, a.y * sc, 1.0f, 0); w = __builtin_amdgcn_cvt_scalef32_pk_fp4_f32(w, a.z * sc, a.w * sc, 1.0f, 1);
    w = __builtin_amdgcn_cvt_scalef32_pk_fp4_f32(w, b.x * sc, b.y * sc, 1.0f, 2); w = __builtin_amdgcn_cvt_scalef32_pk_fp4_f32(w, b.z * sc, b.w * sc, 1.0f, 3);
    return w; }
__device__ __forceinline__ void peer_gather_token(const unsigned short* XNb, const float* rowss, const unsigned char* U8, const unsigned char* V8, const unsigned short* EXPi, const float* GATEi, float* XS, const float* ngain, unsigned short* Hn, int t, int lane, LAS float* scr) {
    asm volatile("" : "+v"(lane));
    typedef int v8i_t __attribute__((ext_vector_type(8)));
    const int r16 = lane & 15, q4 = lane >> 4;
    LAS float* wact = scr;
    LAS unsigned short* ids16 = (LAS unsigned short*)(scr + 128);
    LAS float* gl = scr + 256;
    LAS unsigned char* x8 = (LAS unsigned char*)(scr + 512);
    const unsigned idw = ((const unsigned*)(EXPi + (size_t)t * 128))[lane];
    const float2 gt2 = *(const float2*)(GATEi + (size_t)t * 128 + 2 * lane);
    float rs_;
    { const float4* rp = (const float4*)(rowss + (size_t)t * 16); const float4 p0 = rp[0], p1 = rp[1], p2 = rp[2], p3 = rp[3];
      rs_ = (((p0.x + p0.y) + (p0.z + p0.w)) + ((p1.x + p1.y) + (p1.z + p1.w))) + (((p2.x + p2.y) + (p2.z + p2.w)) + ((p3.x + p3.y) + (p3.z + p3.w))); }
    const float xsc = (1.0f / sqrtf(rs_ * (1.0f / D) + EPS)) * (1.0f / U8_SCALE);
    { const u32x4* xp = (const u32x4*)(XNb + (size_t)t * D + lane * 16); const u32x4 b0 = xp[0], b1 = xp[1];
      u32x4 w; w.x = pk4_fp8(bflo(b0.x), bfhi(b0.x), bflo(b0.y), bfhi(b0.y)); w.y = pk4_fp8(bflo(b0.z), bfhi(b0.z), bflo(b0.w), bfhi(b0.w));
      w.z = pk4_fp8(bflo(b1.x), bfhi(b1.x), bflo(b1.y), bfhi(b1.y)); w.w = pk4_fp8(bflo(b1.z), bfhi(b1.z), bflo(b1.w), bfhi(b1.w));
      typedef int v4i_w __attribute__((ext_vector_type(4))); *(LAS v4i_w*)(x8 + lane * 16) = __builtin_bit_cast(v4i_w, w); }
    ids16[2 * lane] = (unsigned short)(idw & 0xffffu); ids16[2 * lane + 1] = (unsigned short)(idw >> 16);
    gl[2 * lane] = gt2.x; gl[2 * lane + 1] = gt2.y;
    auto load_u = [&](int G, u32x4 (&uu)[8]) { const unsigned e = ids16[G * 16 + r16]; const unsigned char* ur = U8 + (size_t)e * (D / 2) + q4 * 16;
#pragma unroll
        for (int sI = 0; sI < 8; ++sI) uu[sI] = *(const u32x4*)(ur + sI * 64); };
    auto mfma_u = [&](int G, const u32x4 (&uu)[8]) {
        typedef float f32x4_t_ __attribute__((ext_vector_type(4))); f32x4_t_ a = {0.f, 0.f, 0.f, 0.f};
#pragma unroll
        for (int sI = 0; sI < 8; ++sI) { const u32x4 w = uu[sI]; const v8i_t A = {(int)w.x, (int)w.y, (int)w.z, (int)w.w, 0, 0, 0, 0};
            typedef int v4i_t __attribute__((ext_vector_type(4)));
            const v4i_t Bl = *(const LAS v4i_t*)(x8 + sI * 128 + q4 * 16), Bh = *(const LAS v4i_t*)(x8 + sI * 128 + 64 + q4 * 16);
            const v8i_t Bx = __builtin_shufflevector(Bl, Bh, 0, 1, 2, 3, 4, 5, 6, 7);
            a = __builtin_amdgcn_mfma_scale_f32_16x16x128_f8f6f4(A, Bx, a, 4  , 0  , 0, 0, 0, 0); }
        const int ci = r16 & 3;
        const float a0 = a[0], a1 = a[1], a2 = a[2], a3 = a[3];
        const float v = ci == 0 ? a0 : (ci == 1 ? a1 : (ci == 2 ? a2 : a3));
        const float s = v * xsc;
        const int ei = G * 16 + 4 * q4 + ci;
        const float gate = gl[ei];
        const float z2 = 1.5957691216057308f * (s + 0.044715f * s * s * s);
        const float ge = 0.5f * s * (2.0f - 2.0f * __builtin_amdgcn_rcpf(__expf(z2) + 1.0f));
        if (r16 < 4) wact[ei] = ge * gate * (1.0f / V8_SCALE); };
    float acc[16];
#pragma unroll
    for (int i = 0; i < 16; ++i) acc[i] = 0.f;
    auto load_v = [&](int g, u32x2 (&vv)[8]) {
#pragma unroll
        for (int j = 0; j < 8; ++j) { const unsigned e = ids16[g * 8 + j]; vv[j] = *(const u32x2*)(V8 + (size_t)e * (D / 2) + lane * 8); } };
    auto fma_v = [&](int g, const u32x2 (&vv)[8]) {
#pragma unroll
        for (int j = 0; j < 8; ++j) {
            __builtin_amdgcn_sched_barrier(0);
            const float a = wact[g * 8 + j];
            const unsigned w[2] = {vv[j].x, vv[j].y};
#pragma unroll
            for (int k = 0; k < 2; ++k) {
                const f32x2_t e0 = __builtin_amdgcn_cvt_scalef32_pk_f32_fp4(w[k], 1.0f, 0), e1 = __builtin_amdgcn_cvt_scalef32_pk_f32_fp4(w[k], 1.0f, 1);
                const f32x2_t e2 = __builtin_amdgcn_cvt_scalef32_pk_f32_fp4(w[k], 1.0f, 2), e3 = __builtin_amdgcn_cvt_scalef32_pk_f32_fp4(w[k], 1.0f, 3);
                acc[8 * k + 0] = fmaf(a, e0.x, acc[8 * k + 0]); acc[8 * k + 1] = fmaf(a, e0.y, acc[8 * k + 1]); acc[8 * k + 2] = fmaf(a, e1.x, acc[8 * k + 2]); acc[8 * k + 3] = fmaf(a, e1.y, acc[8 * k + 3]);
                acc[8 * k + 4] = fmaf(a, e2.x, acc[8 * k + 4]); acc[8 * k + 5] = fmaf(a, e2.y, acc[8 * k + 5]); acc[8 * k + 6] = fmaf(a, e3.x, acc[8 * k + 6]); acc[8 * k + 7] = fmaf(a, e3.y, acc[8 * k + 7]);
            }
        } };
    {
        u32x4 uA[8]; u32x2 vA[8], vB[8];
        load_u(0, uA);
#pragma unroll 1
        for (int G = 0; G < 8; ++G) {
            load_v(2 * G, vA);
            mfma_u(G, uA);
            __builtin_amdgcn_sched_barrier(0);
            if (G + 1 < 8) load_u(G + 1, uA);
            if (G > 0) fma_v(2 * G - 1, vB);
            load_v(2 * G + 1, vB);
            fma_v(2 * G, vA);
        }
        fma_v(15, vB);
    }
    float ss = 0.f;
    { const u32x4* bp = (const u32x4*)(XNb + (size_t)t * D + lane * 16); const u32x4 b0 = bp[0], b1 = bp[1];
      const unsigned bw[8] = {b0.x, b0.y, b0.z, b0.w, b1.x, b1.y, b1.z, b1.w};
#pragma unroll
      for (int q = 0; q < 8; ++q) { acc[2 * q] += bflo(bw[q]); acc[2 * q + 1] += bfhi(bw[q]); } }
#pragma unroll
    for (int q = 0; q < 16; ++q) ss = fmaf(acc[q], acc[q], ss);
    if (!Hn) {
        float4* o = (float4*)(XS + (size_t)t * D + lane * 16);
#pragma unroll
        for (int q = 0; q < 4; ++q) o[q] = make_float4(acc[4 * q], acc[4 * q + 1], acc[4 * q + 2], acc[4 * q + 3]);
    } else {
        u32x4 x0, x1;
        x0.x = pkbf(acc[0], acc[1]); x0.y = pkbf(acc[2], acc[3]); x0.z = pkbf(acc[4], acc[5]); x0.w = pkbf(acc[6], acc[7]);
        x1.x = pkbf(acc[8], acc[9]); x1.y = pkbf(acc[10], acc[11]); x1.z = pkbf(acc[12], acc[13]); x1.w = pkbf(acc[14], acc[15]);
        u32x4* xo = (u32x4*)(const_cast<unsigned short*>(XNb) + (size_t)t * D + lane * 16); xo[0] = x0; xo[1] = x1;
    }
    if (Hn) {
        ss = wave_sum(ss);
        const float rn = 1.0f / sqrtf(ss * (1.0f / D) + EPS);
        const float4* g4 = (const float4*)(ngain + lane * 16);
        const float4 ga = g4[0], gb = g4[1], gc = g4[2], gd = g4[3];
        u32x4 w0;
        w0.x = pk4_fp8(acc[0] * rn * ga.x, acc[1] * rn * ga.y, acc[2] * rn * ga.z, acc[3] * rn * ga.w); w0.y = pk4_fp8(acc[4] * rn * gb.x, acc[5] * rn * gb.y, acc[6] * rn * gb.z, acc[7] * rn * gb.w);
        w0.z = pk4_fp8(acc[8] * rn * gc.x, acc[9] * rn * gc.y, acc[10] * rn * gc.z, acc[11] * rn * gc.w); w0.w = pk4_fp8(acc[12] * rn * gd.x, acc[13] * rn * gd.y, acc[14] * rn * gd.z, acc[15] * rn * gd.w);
        *(u32x4*)((unsigned char*)Hn + (size_t)t * D + lane * 16) = w0;
    }
}


template <int MODE>
__device__ __forceinline__ void head_prep_task(int task, unsigned short* base, const float* na_gain, const float* dil_gain, const float2* CS) {
    const int h = task & 7, t = (task >> 3) & (T - 1), which = __builtin_amdgcn_readfirstlane(task >> 17);
    unsigned short* p;
    bool do_rope, do_scale; const float* gain = nullptr;
    if (MODE == 0) { p = base + (size_t)t * 2048 + which * 512 + h * 64; do_rope = true; do_scale = (which == 1); }
    else { const int colbase = (which == 0 ? 0 : which == 1 ? 512 : which == 2 ? 1536 : 2048); p = base + (size_t)t * ODD_IN + colbase + h * 64;
           do_rope = which >= 2; do_scale = (which == 0 || which == 2); gain = (which < 2) ? na_gain + which * 64 : dil_gain + (which - 2) * 64; }
    u32x4 w[8];
#pragma unroll
    for (int i = 0; i < 8; ++i) w[i] = ((const u32x4*)p)[i];
    float v[64];
#pragma unroll
    for (int i = 0; i < 8; ++i) { v[8 * i] = bflo(w[i].x); v[8 * i + 1] = bfhi(w[i].x); v[8 * i + 2] = bflo(w[i].y); v[8 * i + 3] = bfhi(w[i].y);
        v[8 * i + 4] = bflo(w[i].z); v[8 * i + 5] = bfhi(w[i].z); v[8 * i + 6] = bflo(w[i].w); v[8 * i + 7] = bfhi(w[i].w); }
    if (MODE == 1) {
        float ss = 0.f;
#pragma unroll
        for (int i = 0; i < 64; ++i) ss = fmaf(v[i], v[i], ss);
        const float r = 1.0f / sqrtf(ss * (1.0f / 64.0f) + EPS);
#pragma unroll
        for (int i = 0; i < 64; ++i) v[i] = v[i] * r * gain[i];
    }
    if (do_rope) {
        const float4* cp = (const float4*)(CS + (size_t)(t & (S - 1)) * 32);
#pragma unroll
        for (int i = 0; i < 16; ++i) { const float4 c2 = cp[i];
            const float a0 = v[2 * i], b0 = v[2 * i + 32], a1 = v[2 * i + 1], b1 = v[2 * i + 33];
            v[2 * i] = a0 * c2.x - b0 * c2.y; v[2 * i + 32] = b0 * c2.x + a0 * c2.y;
            v[2 * i + 1] = a1 * c2.z - b1 * c2.w; v[2 * i + 33] = b1 * c2.z + a1 * c2.w; }
    }
    const float sc = do_scale ? 0.125f : 1.0f;
#pragma unroll
    for (int i = 0; i < 8; ++i) { u32x4 o; o.x = pkbf(v[8 * i] * sc, v[8 * i + 1] * sc); o.y = pkbf(v[8 * i + 2] * sc, v[8 * i + 3] * sc); o.z = pkbf(v[8 * i + 4] * sc, v[8 * i + 5] * sc); o.w = pkbf(v[8 * i + 6] * sc, v[8 * i + 7] * sc);
        ((u32x4*)p)[i] = o; }
}


__device__ __forceinline__ void hy_filters_item(int item, float* smem  , const float* fw1, const float* fb1, const float* fw2, const float* fb2, const float* fw3, const float* fb3,
                                                const float* fw_out, const float* freq, unsigned short* GFf, unsigned short* GFb) {
    const int tid = ltid(), l0 = item * 8;
    float* emb = smem; float* h1 = smem + 8 * 40; float* h2 = h1 + 512; float* h3 = h2 + 512;
    if (tid < 8 * 33) {
        const int pp = tid / 33, k = tid % 33, l = l0 + pp;
        float e;
        if (k == 0) e = (float)l / (float)(S - 1);
        else {
            const int j = (k - 1) & 15;
            const float f = 1e-4f + (float)j * ((15.0f - 1e-4f) / 15.0f);
            const float w = 6.283185307179586f * (float)l / (float)S;
            const float a = f * w;
            e = (k <= 16) ? cosf(a) : -sinf(a);
        }
        emb[pp * 40 + k] = e;
    }
    __syncthreads();
    const int pp = tid >> 6, j = tid & 63;
    { float s = fb1[j];
#pragma unroll 11
      for (int i = 0; i < 33; ++i) s += emb[pp * 40 + i] * fw1[i * 64 + j];
      h1[pp * 64 + j] = sinf(freq[j] * s); }
    __syncthreads();
    { float s = fb2[j];
#pragma unroll 16
      for (int i = 0; i < 64; ++i) s += h1[pp * 64 + i] * fw2[i * 64 + j];
      h2[pp * 64 + j] = sinf(freq[j] * s); }
    __syncthreads();
    { float s = fb3[j];
#pragma unroll 16
      for (int i = 0; i < 64; ++i) s += h2[pp * 64 + i] * fw3[i * 64 + j];
      h3[pp * 64 + j] = sinf(freq[j] * s); }
    __syncthreads();
    const float MAXD = logf(1e-2f) / 0.3f, MIND = logf(1e-2f) / 1.5f;
#pragma unroll 1
    for (int col = tid; col < 2048; col += 512) {
        float acc[8];
#pragma unroll
        for (int q = 0; q < 8; ++q) acc[q] = 0.f;
#pragma unroll 1
        for (int i0 = 0; i0 < 64; i0 += 32) {
            float wv[32];
#pragma unroll
            for (int i = 0; i < 32; ++i) wv[i] = fw_out[(i0 + i) * 2048 + col];
#pragma unroll
            for (int i = 0; i < 32; ++i)
#pragma unroll
                for (int q = 0; q < 8; ++q) acc[q] = fmaf(h3[q * 64 + i0 + i], wv[i], acc[q]);
        }
        const int o = col >> 10, d = (col >> 9) & 1, c = col & 511;
        const float delta = fabsf(MIND + (float)c * ((MAXD - MIND) / 511.0f));
#pragma unroll
        for (int q = 0; q < 8; ++q) { const float tn = (float)(l0 + q) / (float)(S - 1); acc[q] *= expf(-tn * delta) + 0.05f; }
        v4u w; w.x = pk2(acc[0], acc[1]); w.y = pk2(acc[2], acc[3]); w.z = pk2(acc[4], acc[5]); w.w = pk2(acc[6], acc[7]);
        unsigned short* dst = (d ? GFb : GFf) + ((size_t)o * HYC + c) * S + l0;
        *(v4u*)dst = w;
    }
    __syncthreads();
}

constexpr int P0_NFW = 4;
__device__ __forceinline__ void hy_filters_wave(int item, int cw, int lane, LAS float* scr, const float* fw1, const float* fb1, const float* fw2, const float* fb2, const float* fw3, const float* fb3,
                                                const float* fw_out, const float* freq, unsigned short* GFf, unsigned short* GFb) {
    asm volatile("" : "+v"(lane));
    const int l0 = item * 8;
    LAS float* emb = scr; LAS float* h1 = scr + 320; LAS float* h2 = h1 + 512; LAS float* h3 = h2 + 512;
    if (lane < 33) {
#pragma unroll
        for (int pp = 0; pp < 8; ++pp) { const int l = l0 + pp; float e;
            if (lane == 0) e = (float)l / (float)(S - 1);
            else { const int j = (lane - 1) & 15; const float f = 1e-4f + (float)j * ((15.0f - 1e-4f) / 15.0f); const float w = 6.283185307179586f * (float)l / (float)S; const float a = f * w;
                   e = (lane <= 16) ? cosf(a) : -sinf(a); }
            emb[pp * 40 + lane] = e; }
    }
    __builtin_amdgcn_wave_barrier();
    const float fq = freq[lane];
    { float wv[33];
#pragma unroll
      for (int i = 0; i < 33; ++i) wv[i] = fw1[i * 64 + lane];
      const float bb = fb1[lane];
#pragma unroll 1
      for (int pp = 0; pp < 8; ++pp) { float s = bb;
#pragma unroll
          for (int i = 0; i < 33; ++i) s = fmaf(emb[pp * 40 + i], wv[i], s);
          h1[pp * 64 + lane] = sinf(fq * s); } }
    __builtin_amdgcn_wave_barrier();
    { float wv[64];
#pragma unroll
      for (int i = 0; i < 64; ++i) wv[i] = fw2[i * 64 + lane];
      const float bb = fb2[lane];
#pragma unroll 1
      for (int pp = 0; pp < 8; ++pp) { float s = bb;
#pragma unroll
          for (int i = 0; i < 64; ++i) s = fmaf(h1[pp * 64 + i], wv[i], s);
          h2[pp * 64 + lane] = sinf(fq * s); } }
    __builtin_amdgcn_wave_barrier();
    { float wv[64];
#pragma unroll
      for (int i = 0; i < 64; ++i) wv[i] = fw3[i * 64 + lane];
      const float bb = fb3[lane];
#pragma unroll 1
      for (int pp = 0; pp < 8; ++pp) { float s = bb;
#pragma unroll
          for (int i = 0; i < 64; ++i) s = fmaf(h2[pp * 64 + i], wv[i], s);
          h3[pp * 64 + lane] = sinf(fq * s); } }
    __builtin_amdgcn_wave_barrier();
    const float MAXD = logf(1e-2f) / 0.3f, MIND = logf(1e-2f) / 1.5f;
#pragma unroll 1
    for (int col = cw * 64 + lane; col < 2048; col += P0_NFW * 64) {
        float acc[8];
#pragma unroll
        for (int q = 0; q < 8; ++q) acc[q] = 0.f;
#pragma unroll 1
        for (int i0 = 0; i0 < 64; i0 += 32) {
            float wv[32];
#pragma unroll
            for (int i = 0; i < 32; ++i) wv[i] = fw_out[(i0 + i) * 2048 + col];
#pragma unroll
            for (int i = 0; i < 32; ++i)
#pragma unroll
                for (int q = 0; q < 8; ++q) acc[q] = fmaf(h3[q * 64 + i0 + i], wv[i], acc[q]);
        }
        const int o = col >> 10, d = (col >> 9) & 1, c = col & 511;
        const float delta = fabsf(MIND + (float)c * ((MAXD - MIND) / 511.0f));
#pragma unroll
        for (int q = 0; q < 8; ++q) { const float tn = (float)(l0 + q) / (float)(S - 1); acc[q] *= expf(-tn * delta) + 0.05f; }
        v4u w; w.x = pk2(acc[0], acc[1]); w.y = pk2(acc[2], acc[3]); w.z = pk2(acc[4], acc[5]); w.w = pk2(acc[6], acc[7]);
        unsigned short* dst = (d ? GFb : GFf) + ((size_t)o * HYC + c) * S + l0;
        *(v4u*)dst = w;
    }
}

constexpr int HY_TABCNT = 8;
constexpr int HY_ROWV = 2056;
constexpr int HY_VZ_BYTES = 16 * HY_ROWV * 2;
constexpr int HY_GSTRIDE = 8224;
constexpr int HY_GCH = 4 * HY_GSTRIDE;
constexpr int HY_GC_OFF = HY_VZ_BYTES;
constexpr int HY_ZP_OFF = HY_GC_OFF + 2 * HY_GCH;
static_assert(HY_ZP_OFF + 64 <= 147456, "hyena LDS map");

__device__ __forceinline__ void hy_short4(const unsigned short* row, int n0, float w0, float w1, float w2, float bias, float (&o)[4]) {
    const uint2 w = *(const uint2*)(row + n0);
    const float e0 = bflo(w.x), e1 = bfhi(w.x), e2 = bflo(w.y), e3 = bfhi(w.y);
    const float pvl = bf2f(row[n0 > 0 ? n0 - 1 : 0]), nxl = bf2f(row[(n0 + 4 < S) ? n0 + 4 : S - 1]);
    const float pv = n0 > 0 ? pvl : 0.f, nx = (n0 + 4 < S) ? nxl : 0.f;
    o[0] = pv * w0 + e0 * w1 + e1 * w2 + bias; o[1] = e0 * w0 + e1 * w1 + e2 * w2 + bias;
    o[2] = e1 * w0 + e2 * w1 + e3 * w2 + bias; o[3] = e2 * w0 + e3 * w1 + nx * w2 + bias;
}
constexpr int HY_STG_OFF = HY_ZP_OFF + 64;
static_assert(HY_STG_OFF + 8192 <= 147456 - 64, "hyena LDS map (staging)");
__device__ __forceinline__ v4u hy_load_taps(const unsigned short* GFf, const unsigned short* GFb, int o, int c) { const int tid = ltid(); return *(const v4u*)((tid < 256 ? GFf : GFb) + ((size_t)o * HYC + c) * S + (tid & 255) * 8); }
__device__ __forceinline__ void hy_fill_filter(LAS unsigned char* lds, v4u w0, v4u w1) {
    const int tid = ltid();
#pragma unroll 1
    for (int ch = 0; ch < 2; ++ch) {
        const v4u w = ch ? w1 : w0;
        __syncthreads();
        *(LAS v4u*)(lds + HY_STG_OFF + tid * 16) = w;
        __syncthreads();
        const LAS unsigned short* F = (const LAS unsigned short*)(lds + HY_STG_OFF);
        const LAS unsigned short* Bw = F + S;
#pragma unroll 1
        for (int gi = tid; gi < 4 * 1026; gi += 512) {
            const int s = gi / 1026, q = gi % 1026;
            unsigned e[4];
#pragma unroll
            for (int k = 0; k < 4; ++k) { const int x = 4 * (q - 512) - s + k; const int ax = x < 0 ? -x : x; const int cx = ax > 2047 ? 2047 : ax;
                const unsigned v = (x <= 0) ? F[cx] : Bw[cx]; e[k] = (ax > 2047) ? 0u : v; }
            u32x2 wv; wv.x = e[0] | (e[1] << 16); wv.y = e[2] | (e[3] << 16);
            *(LAS u32x2*)(lds + HY_GC_OFF + ch * HY_GCH + s * HY_GSTRIDE + q * 8) = wv;
        }
    }
}
struct TabJob { const float* pu; const float* pv; const float* gain; unsigned* ub; unsigned* vb; size_t first, stride, end; int cnt; };
typedef float f4nt_t __attribute__((ext_vector_type(4)));
__device__ __forceinline__ void tab_issue(const TabJob& jb, int j, f4nt_t (&X)[4]) {
    size_t pi = jb.first + (size_t)j * jb.stride; pi = pi < jb.end ? pi : jb.end - 1;
    X[0] = __builtin_nontemporal_load((const f4nt_t*)jb.pu + 2 * pi); X[1] = __builtin_nontemporal_load((const f4nt_t*)jb.pu + 2 * pi + 1);
    X[2] = __builtin_nontemporal_load((const f4nt_t*)jb.pv + 2 * pi); X[3] = __builtin_nontemporal_load((const f4nt_t*)jb.pv + 2 * pi + 1);
}
__device__ __forceinline__ void tab_convert(const TabJob& jb, int j, const f4nt_t (&X)[4], float4 g0, float4 g1) {
    const size_t pi = jb.first + (size_t)j * jb.stride;
    const float4 a0 = make_float4(X[0].x * g0.x, X[0].y * g0.y, X[0].z * g0.z, X[0].w * g0.w), a1 = make_float4(X[1].x * g1.x, X[1].y * g1.y, X[1].z * g1.z, X[1].w * g1.w);
    const float4 c0 = make_float4(X[2].x, X[2].y, X[2].z, X[2].w), c1 = make_float4(X[3].x, X[3].y, X[3].z, X[3].w);
    const unsigned uw = pk8_fp4(a0, a1, U8_SCALE), vw = pk8_fp4(c0, c1, V8_SCALE);
    if (pi < jb.end) { jb.ub[pi] = uw; jb.vb[pi] = vw; }
}
__device__ __forceinline__ void hy_conv_mfma(LAS unsigned char* lds, int wave, int lane, f32x16 (&acc)[2][2], const TabJob& jb) {
    const int r = lane & 31, hh = lane >> 5, ch = wave >> 2, cg = wave & 3;
#pragma unroll
    for (int a = 0; a < 2; ++a)
#pragma unroll
        for (int b = 0; b < 2; ++b)
#pragma unroll
            for (int i = 0; i < 16; ++i) acc[a][b][i] = 0.f;
    const int a_base = HY_GC_OFF + ch * HY_GCH + (r & 3) * HY_GSTRIDE + (512 + 2 * hh - (r >> 2)) * 8;
    const int b_base = ((ch * 8 + (r & 7)) * HY_ROWV + 64 * (8 * cg + (r >> 3)) + 8 * hh) * 2;
    const int dlo = 8 * cg - 31, dhi = 8 * cg + 7;
    float4 g0 = make_float4(0.f, 0.f, 0.f, 0.f), g1 = g0;
    if (jb.cnt > 0) { const float4* gq = (const float4*)(jb.gain + (size_t)((jb.first * 8) & (D - 1))); g0 = gq[0]; g1 = gq[1]; }
    f4nt_t XA[4];
#pragma unroll
    for (int i = 0; i < 4; ++i) XA[i] = (f4nt_t){0.f, 0.f, 0.f, 0.f};
    auto body = [&](int dl, int it, f4nt_t (&X)[4]) {
        if ((it & 3) == 3 && (it >> 2) < jb.cnt) tab_convert(jb, it >> 2, X, g0, g1);
        if ((it & 3) == 0 && (it >> 2) < jb.cnt) tab_issue(jb, it >> 2, X);
        const int sh = -128 * dl;
        bf16x8 A[2][4];
#pragma unroll
        for (int mh = 0; mh < 2; ++mh)
#pragma unroll
            for (int ks = 0; ks < 4; ++ks) {
                const LAS unsigned char* p = lds + (a_base + sh + (4 * ks - 8 * mh) * 8);
                const u32x2 lo = *(const LAS u32x2*)p, hi = *(const LAS u32x2*)(p + 8);
                u32x4 w; w.x = lo.x; w.y = lo.y; w.z = hi.x; w.w = hi.y;
                A[mh][ks] = __builtin_bit_cast(bf16x8, w);
            }
#pragma unroll
        for (int sub = 0; sub < 2; ++sub) {
            if (dl >= 8 * cg + 4 * sub - 31 && dl <= 8 * cg + 4 * sub + 3) {
                const int J = 8 * cg + 4 * sub + (r >> 3) - dl;
                const bool ok = (unsigned)J < 32u;
#pragma unroll
                for (int ks = 0; ks < 4; ++ks) {
                    const int addr = ok ? (b_base + sh + 512 * sub + 32 * ks) : HY_ZP_OFF;
                    const bf16x8 Bf = *(const LAS bf16x8*)(lds + addr);
                    acc[0][sub] = __builtin_amdgcn_mfma_f32_32x32x16_bf16(A[0][ks], Bf, acc[0][sub], 0, 0, 0);
                    acc[1][sub] = __builtin_amdgcn_mfma_f32_32x32x16_bf16(A[1][ks], Bf, acc[1][sub], 0, 0, 0);
                }
            }
        }
    };
#pragma unroll 1
    for (int dl = dlo, it = 0; dl <= dhi; ++dl, ++it) body(dl, it, XA);
    static_assert(4 * HY_TABCNT <= 39, "the 39-iteration convolution loop must cover its table items");
}
__device__ __forceinline__ void hy_epilogue(LAS unsigned char* lds, int wave, int lane, const f32x16 (&acc)[2][2], const unsigned short* HYT, int gate_row, float w0, float w1, float w2, float bias, float skip) {
    const int r = lane & 31, hh = lane >> 5, ch = wave >> 2, cg = wave & 3, b = r & 7;
    const unsigned short* grow = HYT + (size_t)gate_row * T + (size_t)b * S;
#pragma unroll
    for (int mh = 0; mh < 2; ++mh)
#pragma unroll
        for (int sub = 0; sub < 2; ++sub)
#pragma unroll
            for (int qd = 0; qd < 4; ++qd) {
                const int I = 8 * cg + 4 * sub + (r >> 3), n0 = 64 * I + 32 * mh + 8 * qd + 4 * hh;
                float g[4]; hy_short4(grow, n0, w0, w1, w2, bias, g);
                LAS u32x2* vp = (LAS u32x2*)(lds + ((ch * 8 + b) * HY_ROWV + n0) * 2);
                const u32x2 vw = *vp;
                const float y0 = acc[mh][sub][4 * qd], y1 = acc[mh][sub][4 * qd + 1], y2 = acc[mh][sub][4 * qd + 2], y3 = acc[mh][sub][4 * qd + 3];
                u32x2 ow;
                ow.x = pk2(g[0] * (y0 + skip * bflo(vw.x)), g[1] * (y1 + skip * bfhi(vw.x)));
                ow.y = pk2(g[2] * (y2 + skip * bflo(vw.y)), g[3] * (y3 + skip * bfhi(vw.y)));
                *vp = ow;
            }
}
__device__ __forceinline__ void hy_unit(int cp, LAS unsigned char* lds, const unsigned short* HYT, const unsigned short* GFf, const unsigned short* GFb,
                                        const float* conv_w, const float* conv_b, const float* skip, unsigned short* MIXb, TabJob jb) {
    const int tid = ltid(), lane = tid & 63, wave = __builtin_amdgcn_readfirstlane(tid >> 6);
    jb.first += (size_t)tid;
    const int c0 = 2 * cp;
    if (tid < 16) ((LAS unsigned*)(lds + HY_ZP_OFF))[tid] = 0u;
    const v4u tp00 = hy_load_taps(GFf, GFb, 0, c0), tp01 = hy_load_taps(GFf, GFb, 0, c0 + 1), tp10 = hy_load_taps(GFf, GFb, 1, c0), tp11 = hy_load_taps(GFf, GFb, 1, c0 + 1);
#pragma unroll
    for (int it = 0; it < 8; ++it) {
        const int chunk = it * 512 + tid, ch = chunk >> 11, rem = chunk & 2047, b = rem >> 8, pos0 = (rem & 255) * 8;
        const int c = c0 + ch;
        const float w0 = conv_w[c], w1 = conv_w[HY_IN + c], w2 = conv_w[2 * HY_IN + c], bias = conv_b[c];
        const unsigned short* row = HYT + (size_t)c * T + (size_t)b * S;
        float o0[4], o1[4];
        hy_short4(row, pos0, w0, w1, w2, bias, o0); hy_short4(row, pos0 + 4, w0, w1, w2, bias, o1);
        v4u w; w.x = pk2(o0[0], o0[1]); w.y = pk2(o0[2], o0[3]); w.z = pk2(o1[0], o1[1]); w.w = pk2(o1[2], o1[3]);
        *(LAS v4u*)(lds + ((ch * 8 + b) * HY_ROWV + pos0) * 2) = w;
    }
    hy_fill_filter(lds, tp00, tp01);
    __syncthreads();
    f32x16 acc[2][2];
    hy_conv_mfma(lds, wave, lane, acc, jb);
    __syncthreads();
    {
        const int c = c0 + (wave >> 2), gc = 512 + c;
        hy_epilogue(lds, wave, lane, acc, HYT, gc, conv_w[gc], conv_w[HY_IN + gc], conv_w[2 * HY_IN + gc], conv_b[gc], skip[c]);
    }
    hy_fill_filter(lds, tp10, tp11);
    __syncthreads();
    { TabJob j2 = jb; j2.first += (size_t)jb.cnt * jb.stride; hy_conv_mfma(lds, wave, lane, acc, j2); }
    __syncthreads();
    {
        const int c = c0 + (wave >> 2), gc = 1024 + c;
        hy_epilogue(lds, wave, lane, acc, HYT, gc, conv_w[gc], conv_w[HY_IN + gc], conv_w[2 * HY_IN + gc], conv_b[gc], skip[HYC + c]);
    }
    __syncthreads();
#pragma unroll 1
    for (int t = tid; t < T; t += 512) {
        const int b = t >> 11, pos = t & 2047;
        const unsigned lo = *(const LAS unsigned short*)(lds + ((0 * 8 + b) * HY_ROWV + pos) * 2);
        const unsigned hi = *(const LAS unsigned short*)(lds + ((1 * 8 + b) * HY_ROWV + pos) * 2);
        *(unsigned*)(MIXb + (size_t)t * D + c0) = lo | (hi << 16);
    }
    __syncthreads();
}


typedef __bf16 bf2_t __attribute__((ext_vector_type(2)));
__device__ __forceinline__ int crow32(int i, int hh) { return (i & 3) + 8 * (i >> 2) + 4 * hh; }
constexpr int AT_KT_BYTES = 8192, AT_VT_BYTES = 8192, AT_BUF_BYTES = AT_KT_BYTES + AT_VT_BYTES;
typedef short s16x4_t __attribute__((ext_vector_type(4)));
constexpr int AT_TAB_OFF = 6 * AT_BUF_BYTES;
constexpr int AT_ST_OFF = 65536;
struct AtTile { const unsigned short* K; const unsigned short* V; int pitch; int row0, rstride, rmin, rmax; };

template <class Pol>
__device__ __forceinline__ void attn_unit(Pol& pol, LAS unsigned char* lds) {
    const int tid = ltid(), lane = tid & 63, r = lane & 31, hh = lane >> 5;
    const int skey = tid >> 3, sc = tid & 7;
    const int tq = (lane & 15) >> 2, tp = lane & 3, tblk = (lane >> 4) & 1;
    bf16x8 Qf[4];
    { const unsigned short* qp = pol.qptr(r);
#pragma unroll
      for (int ks = 0; ks < 4; ++ks) Qf[ks] = *(const bf16x8*)(qp + 16 * ks + 8 * hh); }
    f32x16 O[2];
#pragma unroll
    for (int dt = 0; dt < 2; ++dt)
#pragma unroll
        for (int i = 0; i < 16; ++i) O[dt][i] = 0.f;
    float Ls = 0.f;
    if constexpr (Pol::PRE && !Pol::RESIDENT) pol.pre(O, Qf, lds, r, hh);
    const int nt = pol.ntiles();
    u32x4 kA, vA, kB, vB;
    auto g_load = [&](int j, u32x4& kreg, u32x4& vreg) { const AtTile t = pol.tile(j); int row = t.row0 + skey * t.rstride; row = row < t.rmin ? t.rmin : (row > t.rmax ? t.rmax : row);
        kreg = *(const u32x4*)(t.K + (size_t)row * t.pitch + sc * 8); vreg = *(const u32x4*)(t.V + (size_t)row * t.pitch + sc * 8); };
    auto l_store = [&](int buf, int jt, u32x4 kreg, u32x4 vreg) { LAS unsigned char* kt = lds + buf * AT_BUF_BYTES; LAS unsigned char* vt = kt + AT_KT_BYTES;
        if constexpr (Pol::KSCALE) { const float c = pol.kscale(jt, skey);
            kreg.x = pkbf(bflo(kreg.x) * c, bfhi(kreg.x) * c); kreg.y = pkbf(bflo(kreg.y) * c, bfhi(kreg.y) * c); kreg.z = pkbf(bflo(kreg.z) * c, bfhi(kreg.z) * c); kreg.w = pkbf(bflo(kreg.w) * c, bfhi(kreg.w) * c); }
        *(LAS u32x4*)(kt + skey * 128 + ((sc ^ (skey & 7)) * 16)) = kreg;
        *(LAS u32x4*)(vt + skey * 128 + ((sc ^ (((skey >> 1) & 1) << 2)) * 16)) = vreg; };
    auto compute = [&](int j, int buf) {
        if (pol.active(j)) {
            const LAS unsigned char* kt = lds + buf * AT_BUF_BYTES; const LAS unsigned char* vt = kt + AT_KT_BYTES;
            f32x16 Sx[2];
#pragma unroll
            for (int kh = 0; kh < 2; ++kh) {
#pragma unroll
                for (int i = 0; i < 16; ++i) Sx[kh][i] = 0.f;
                const int key = kh * 32 + r;
#pragma unroll
                for (int ks = 0; ks < 4; ++ks) { const bf16x8 A = *(const LAS bf16x8*)(kt + key * 128 + (((2 * ks + hh) ^ (key & 7)) * 16));
                    Sx[kh] = __builtin_amdgcn_mfma_f32_32x32x16_bf16(A, Qf[ks], Sx[kh], 0, 0, 0); }
            }
            bf16x8 Pf[2][2];
            pol.scores(Sx, j, hh, Ls);
#pragma unroll
            for (int kh = 0; kh < 2; ++kh) {
                float pv[16];
#pragma unroll
                for (int i = 0; i < 16; ++i) pv[i] = Sx[kh][i];
#pragma unroll
                for (int s = 0; s < 2; ++s) { u32x4 w; w.x = pkbf(pv[8 * s], pv[8 * s + 1]); w.y = pkbf(pv[8 * s + 2], pv[8 * s + 3]); w.z = pkbf(pv[8 * s + 4], pv[8 * s + 5]); w.w = pkbf(pv[8 * s + 6], pv[8 * s + 7]);
                    Pf[kh][s] = __builtin_bit_cast(bf16x8, w); }
            }
#pragma unroll
            for (int dt = 0; dt < 2; ++dt)
#pragma unroll
                for (int kh = 0; kh < 2; ++kh)
#pragma unroll
                    for (int s = 0; s < 2; ++s) { if (!pol.pv_live(kh, s)) continue;
                        const int key_lo = kh * 32 + 16 * s + 4 * hh + tq, cch = (4 * dt + 2 * tblk + (tp >> 1)) ^ (((tq >> 1) & 1) << 2);
                        const LAS unsigned char* ap = vt + key_lo * 128 + cch * 16 + (tp & 1) * 8;
                        const s16x4_t lo = __builtin_amdgcn_ds_read_tr16_b64_v4i16((LAS s16x4_t*)ap), hi = __builtin_amdgcn_ds_read_tr16_b64_v4i16((LAS s16x4_t*)(ap + 8 * 128));
                        const bf16x8 A = __builtin_shufflevector(lo, hi, 0, 1, 2, 3, 4, 5, 6, 7);
                        O[dt] = __builtin_amdgcn_mfma_f32_32x32x16_bf16(A, Pf[kh][s], O[dt], 0, 0, 0); }
        } };
    if constexpr (Pol::RESIDENT) {
        constexpr int NT = Pol::NT;
        const int nt = pol.ntiles();
        u32x4 kr[NT], vr[NT];
#pragma unroll
        for (int j = 0; j < NT; ++j) g_load(j < nt ? j : nt - 1, kr[j], vr[j]);
        if constexpr (Pol::PRE) pol.pre(O, Qf, lds, r, hh);
#pragma unroll 1
        for (int b0 = 0; b0 < nt; b0 += NT) {
            __syncthreads();
#pragma unroll
            for (int j = 0; j < NT; ++j) l_store(j, b0 + j, kr[j], vr[j]);
            if (b0 + NT < nt) {
#pragma unroll
                for (int j = 0; j < NT; ++j) { const int jn = b0 + NT + j; g_load(jn < nt ? jn : nt - 1, kr[j], vr[j]); }
            }
            __syncthreads();
#pragma unroll 1
            for (int j = 0; j < NT; ++j) if (b0 + j < nt) compute(b0 + j, j);
        }
        Ls += __shfl_xor(Ls, 32);
        pol.finish(O, Ls, r, hh);
        return;
    }
    g_load(0, kA, vA); l_store(0, 0, kA, vA);
    if (nt > 1) g_load(1, kA, vA);
    __syncthreads();
#pragma unroll 1
    for (int j = 0; j < nt; j += 2) {
        if (j + 2 < nt) g_load(j + 2, kB, vB);
        compute(j, j & 1);
        if (j + 1 < nt) l_store((j + 1) & 1, j + 1, kA, vA);
        __syncthreads();
        if (j + 1 >= nt) break;
        if (j + 3 < nt) g_load(j + 3, kA, vA);
        compute(j + 1, (j + 1) & 1);
        if (j + 2 < nt) l_store((j + 2) & 1, j + 2, kB, vB);
        __syncthreads();
    }
    Ls += __shfl_xor(Ls, 32);
    pol.finish(O, Ls, r, hh);
}

__device__ __forceinline__ void ret_kv_unit(int item, const unsigned short* RET, const float* log_decay, float* LT, LAS unsigned char* lds) {
    const int tid = ltid(), lane = tid & 63, wave = __builtin_amdgcn_readfirstlane(tid >> 6), r = lane & 31, hh = lane >> 5;
    const int tq = (lane & 15) >> 2, tp = lane & 3, tblk = (lane >> 4) & 1;
    const int b = item >> 6, h = (item >> 3) & 7, c = item & 7;
    const float lgf2 = -expf(log_decay[h]) * 1.4426950408889634f, lgb2 = -expf(log_decay[8 + h]) * 1.4426950408889634f;
    {
        const int key = tid >> 1, ch0 = (tid & 1) * 4, skey = key & 63;
        const unsigned short* kp = RET + (size_t)(b * S + c * 256 + key) * 2048 + 512 + h * 64 + ch0 * 8;
        const float ff = __builtin_amdgcn_exp2f(lgf2 * (float)(255 - key)), fb = __builtin_amdgcn_exp2f(lgb2 * (float)key);
        u32x4 kr[4], vr[4];
#pragma unroll
        for (int i = 0; i < 4; ++i) { kr[i] = ((const u32x4*)kp)[i]; vr[i] = ((const u32x4*)(kp + 512))[i]; }
#pragma unroll
        for (int i = 0; i < 4; ++i) { const int so = (key >> 6) * 8192 + skey * 128 + (((ch0 + i) ^ (((skey >> 1) & 1) << 2)) * 16);
            const unsigned x = kr[i].x, y = kr[i].y, z = kr[i].z, w = kr[i].w;
            u32x4 kf, kb; kf.x = pkbf(bflo(x) * ff, bfhi(x) * ff); kf.y = pkbf(bflo(y) * ff, bfhi(y) * ff); kf.z = pkbf(bflo(z) * ff, bfhi(z) * ff); kf.w = pkbf(bflo(w) * ff, bfhi(w) * ff);
            kb.x = pkbf(bflo(x) * fb, bfhi(x) * fb); kb.y = pkbf(bflo(y) * fb, bfhi(y) * fb); kb.z = pkbf(bflo(z) * fb, bfhi(z) * fb); kb.w = pkbf(bflo(w) * fb, bfhi(w) * fb);
            *(LAS u32x4*)(lds + so) = kf; *(LAS u32x4*)(lds + 32768 + so) = kb; *(LAS u32x4*)(lds + 65536 + so) = vr[i]; }
    }
    __syncthreads();
    const int dir = wave >> 2, eb = (wave >> 1) & 1, db = wave & 1;
    const LAS unsigned char* kt = lds + dir * 32768; const LAS unsigned char* vt = lds + 65536;
    f32x16 acc;
#pragma unroll
    for (int i = 0; i < 16; ++i) acc[i] = 0.f;
    const int swz = ((tq >> 1) & 1) << 2;
#pragma unroll
    for (int st = 0; st < 4; ++st)
#pragma unroll
        for (int g = 0; g < 4; ++g) {
            const int key_lo = 16 * g + 4 * hh + tq;
            const LAS unsigned char* ap = kt + st * 8192 + key_lo * 128 + (((4 * eb + 2 * tblk + (tp >> 1)) ^ swz) * 16) + (tp & 1) * 8;
            const LAS unsigned char* bp = vt + st * 8192 + key_lo * 128 + (((4 * db + 2 * tblk + (tp >> 1)) ^ swz) * 16) + (tp & 1) * 8;
            const s16x4_t alo = __builtin_amdgcn_ds_read_tr16_b64_v4i16((LAS s16x4_t*)ap), ahi = __builtin_amdgcn_ds_read_tr16_b64_v4i16((LAS s16x4_t*)(ap + 8 * 128));
            const s16x4_t blo = __builtin_amdgcn_ds_read_tr16_b64_v4i16((LAS s16x4_t*)bp), bhi = __builtin_amdgcn_ds_read_tr16_b64_v4i16((LAS s16x4_t*)(bp + 8 * 128));
            const bf16x8 A = __builtin_shufflevector(alo, ahi, 0, 1, 2, 3, 4, 5, 6, 7), B = __builtin_shufflevector(blo, bhi, 0, 1, 2, 3, 4, 5, 6, 7);
            acc = __builtin_amdgcn_mfma_f32_32x32x16_bf16(A, B, acc, 0, 0, 0); }
    float* out = LT + ((size_t)item * 2 + dir) * 4096 + (32 * db + r) * 64 + 32 * eb + 4 * hh;
#pragma unroll
    for (int g = 0; g < 4; ++g) *(float4*)(out + 8 * g) = make_float4(acc[4 * g], acc[4 * g + 1], acc[4 * g + 2], acc[4 * g + 3]);
    __syncthreads();
}
struct RetPol {
    const unsigned short* RET; const float* gn_gain; unsigned short* MIXb; const float* LT; int b, h, q0; float lgf2, lgb2; int qpos;
    __device__ __forceinline__ void init(int unit, const unsigned short* RET_, const float* log_decay, const float* gn, unsigned short* MIXb_, const float* LT_) {
        RET = RET_; gn_gain = gn; MIXb = MIXb_; LT = LT_; b = unit >> 6; h = (unit >> 3) & 7; q0 = (unit & 7) * 256;
        lgf2 = -expf(log_decay[h]) * 1.4426950408889634f; lgb2 = -expf(log_decay[8 + h]) * 1.4426950408889634f;
        qpos = q0 + (ltid() >> 6) * 32 + (ltid() & 31);
    }
    __device__ __forceinline__ const unsigned short* qptr(int) const { return RET + (size_t)(b * S + qpos) * 2048 + h * 64; }
    __device__ __forceinline__ int ntiles() const { return 4; }
    __device__ __forceinline__ AtTile tile(int j) const { return AtTile{RET + 512 + h * 64, RET + 1024 + h * 64, 2048, b * S + q0 + 64 * j, 1, 0, T - 1}; }
    __device__ __forceinline__ bool active(int) const { return true; }
    static constexpr bool KSCALE = false, PRE = true, RESIDENT = true; static constexpr int NT = 4;
    __device__ __forceinline__ bool pv_live(int, int) const { return true; }
    __device__ __forceinline__ float kscale(int, int) const { return 1.0f; }
    __device__ __forceinline__ void scores(f32x16 (&Sx)[2], int j, int hh, float&) const {
        const int qk = qpos - q0 - 64 * j;
#pragma unroll
        for (int kh = 0; kh < 2; ++kh)
#pragma unroll
            for (int i = 0; i < 16; ++i) { const int diff = qk - (kh * 32 + crow32(i, hh)); const float e = diff >= 0 ? lgf2 * (float)diff : -lgb2 * (float)diff;
                const float sv = Sx[kh][i]; Sx[kh][i] = sv * __builtin_amdgcn_exp2f(e); }
    }
    __device__ __forceinline__ void pre(f32x16 (&O)[2], const bf16x8 (&Qf)[4], LAS unsigned char* lds, int r, int hh) const {
        LAS unsigned char* st = lds + AT_ST_OFF;
        {   const int tid = ltid(), d = tid >> 3, ech = tid & 7, c = q0 >> 8;
            const float* base = LT + (size_t)((b * 8 + h) * 8) * 8192 + d * 64 + ech * 8;
            float4 af0 = make_float4(0.f, 0.f, 0.f, 0.f), af1 = af0, ab0 = af0, ab1 = af0;
#pragma unroll
            for (int k = 1; k < 8; ++k) { const int cp = (c + k) & 7; const bool bw = cp > c; const int dist = bw ? cp - c : c - cp;
                const float w = __builtin_amdgcn_exp2f((bw ? lgb2 : lgf2) * (float)(256 * dist - 255)), wf = bw ? 0.f : w, wb = bw ? w : 0.f;
                const float4* p = (const float4*)(base + (size_t)(cp * 2 + (bw ? 1 : 0)) * 4096); const float4 x0 = p[0], x1 = p[1];
                af0.x = fmaf(wf, x0.x, af0.x); af0.y = fmaf(wf, x0.y, af0.y); af0.z = fmaf(wf, x0.z, af0.z); af0.w = fmaf(wf, x0.w, af0.w);
                af1.x = fmaf(wf, x1.x, af1.x); af1.y = fmaf(wf, x1.y, af1.y); af1.z = fmaf(wf, x1.z, af1.z); af1.w = fmaf(wf, x1.w, af1.w);
                ab0.x = fmaf(wb, x0.x, ab0.x); ab0.y = fmaf(wb, x0.y, ab0.y); ab0.z = fmaf(wb, x0.z, ab0.z); ab0.w = fmaf(wb, x0.w, ab0.w);
                ab1.x = fmaf(wb, x1.x, ab1.x); ab1.y = fmaf(wb, x1.y, ab1.y); ab1.z = fmaf(wb, x1.z, ab1.z); ab1.w = fmaf(wb, x1.w, ab1.w); }
            u32x4 wfv, wbv; wfv.x = pkbf(af0.x, af0.y); wfv.y = pkbf(af0.z, af0.w); wfv.z = pkbf(af1.x, af1.y); wfv.w = pkbf(af1.z, af1.w);
            wbv.x = pkbf(ab0.x, ab0.y); wbv.y = pkbf(ab0.z, ab0.w); wbv.z = pkbf(ab1.x, ab1.y); wbv.w = pkbf(ab1.z, ab1.w);
            const int so = d * 128 + ((ech ^ (d & 7)) * 16);
            *(LAS u32x4*)(st + so) = wfv; *(LAS u32x4*)(st + 8192 + so) = wbv; }
        __syncthreads();
#pragma unroll
        for (int dir = 0; dir < 2; ++dir) {
            const float qs = dir ? __builtin_amdgcn_exp2f(lgb2 * (float)(q0 + 255 - qpos)) : __builtin_amdgcn_exp2f(lgf2 * (float)(qpos - q0));
#pragma unroll
            for (int ks = 0; ks < 4; ++ks) { const u32x4 qw = __builtin_bit_cast(u32x4, Qf[ks]); const unsigned x = qw.x, y = qw.y, z = qw.z, w = qw.w;
                u32x4 sw; sw.x = pkbf(bflo(x) * qs, bfhi(x) * qs); sw.y = pkbf(bflo(y) * qs, bfhi(y) * qs); sw.z = pkbf(bflo(z) * qs, bfhi(z) * qs); sw.w = pkbf(bflo(w) * qs, bfhi(w) * qs);
                const bf16x8 Qs = __builtin_bit_cast(bf16x8, sw);
#pragma unroll
                for (int dt = 0; dt < 2; ++dt) { const int row = 32 * dt + r;
                    const bf16x8 A = *(const LAS bf16x8*)(st + dir * 8192 + row * 128 + (((2 * ks + hh) ^ (row & 7)) * 16));
                    O[dt] = __builtin_amdgcn_mfma_f32_32x32x16_bf16(A, Qs, O[dt], 0, 0, 0); } }
        }
    }
    __device__ __forceinline__ void finish(const f32x16 (&O)[2], float, int, int hh) const {
        float ss = 0.f;
#pragma unroll
        for (int dt = 0; dt < 2; ++dt)
#pragma unroll
            for (int i = 0; i < 16; ++i) ss = fmaf(O[dt][i], O[dt][i], ss);
        ss += __shfl_xor(ss, 32);
        const float rs = 1.0f / sqrtf(ss * (1.0f / 64.0f) + EPS);
        const size_t t = (size_t)b * S + qpos;
#pragma unroll
        for (int dt = 0; dt < 2; ++dt)
#pragma unroll
            for (int qd = 0; qd < 4; ++qd) { const int d = 32 * dt + 8 * qd + 4 * hh;
                const uint2 gw = *(const uint2*)(RET + t * 2048 + 1536 + h * 64 + d);
                const float4 gg = *(const float4*)(gn_gain + h * 64 + d);
                const float g0 = bflo(gw.x), g1 = bfhi(gw.x), g2 = bflo(gw.y), g3 = bfhi(gw.y);
                const float o0 = g0 / (1.0f + __expf(-g0)) * (O[dt][4 * qd] * rs * gg.x), o1 = g1 / (1.0f + __expf(-g1)) * (O[dt][4 * qd + 1] * rs * gg.y);
                const float o2 = g2 / (1.0f + __expf(-g2)) * (O[dt][4 * qd + 2] * rs * gg.z), o3 = g3 / (1.0f + __expf(-g3)) * (O[dt][4 * qd + 3] * rs * gg.w);
                uint2 ow; ow.x = pkbf(o0, o1); ow.y = pkbf(o2, o3);
                *(uint2*)(MIXb + t * D + 512 + h * 64 + d) = ow; }
    }
};

struct NaPol {
    static constexpr bool KSCALE = false, PRE = false, RESIDENT = true; static constexpr int NT = 6;
    const unsigned short* PJ; unsigned short* MIXb; const LAS float* btab; int b, h, g4, kr_lo, nt_, qrow, qcol, r0, wpar;
    int offF[16], offP[4];
    __device__ __forceinline__ void scores(f32x16 (&Sx)[2], int j, int hh, float& Ls) const {
        const int ro = __builtin_amdgcn_readfirstlane(kr_lo + j - qrow + 7);
        const LAS unsigned char* rowp = (const LAS unsigned char*)btab + ro * 128;
        if (wpar == 0) {
#pragma unroll
            for (int i = 0; i < 16; ++i) { const float sv = Sx[0][i]; const float pvv = __builtin_amdgcn_exp2f(fmaf(sv, 1.4426950408889634f, *(const LAS float*)(rowp + offF[i]))); Sx[0][i] = pvv; Ls += pvv; }
#pragma unroll
            for (int i = 0; i < 4; ++i) { const float sv = Sx[1][i]; const float pvv = __builtin_amdgcn_exp2f(fmaf(sv, 1.4426950408889634f, *(const LAS float*)(rowp + offP[i]))); Sx[1][i] = pvv; Ls += pvv; }
#pragma unroll
            for (int i = 4; i < 8; ++i) Sx[1][i] = 0.f;
        } else {
#pragma unroll
            for (int i = 0; i < 16; ++i) { const float sv = Sx[1][i]; const float pvv = __builtin_amdgcn_exp2f(fmaf(sv, 1.4426950408889634f, *(const LAS float*)(rowp + offF[i]))); Sx[1][i] = pvv; Ls += pvv; }
#pragma unroll
            for (int i = 0; i < 4; ++i) { const float sv = Sx[0][12 + i]; const float pvv = __builtin_amdgcn_exp2f(fmaf(sv, 1.4426950408889634f, *(const LAS float*)(rowp + offP[i]))); Sx[0][12 + i] = pvv; Ls += pvv; }
#pragma unroll
            for (int i = 8; i < 12; ++i) Sx[0][i] = 0.f;
        }
    }
    __device__ __forceinline__ bool pv_live(int kh, int s) const { return wpar == 0 ? !(kh == 1 && s == 1) : !(kh == 0 && s == 0); }
    __device__ __forceinline__ void init(int unit, const unsigned short* PJ_, unsigned short* MIXb_, const LAS float* btab_) {
        PJ = PJ_; MIXb = MIXb_; btab = btab_; b = unit >> 6; h = (unit >> 3) & 7; g4 = unit & 7;
        const int w = ltid() >> 6, hh_ = (ltid() >> 5) & 1;
        wpar = __builtin_amdgcn_readfirstlane(w & 1);
        qrow = 4 * g4 + (w >> 1); qcol = (w & 1) * 32 + (ltid() & 31);
        r0 = qrow - 4; r0 = r0 < 0 ? 0 : (r0 > 24 ? 24 : r0);
        int c0 = qcol - 8; c0 = c0 < 0 ? 0 : (c0 > 48 ? 48 : c0);
        int lo = 4 * g4 - 4; lo = lo < 0 ? 0 : (lo > 24 ? 24 : lo);
        int hi = 4 * g4 + 3 - 4; hi = hi < 0 ? 0 : (hi > 24 ? 24 : hi);
        kr_lo = lo; nt_ = hi + 7 - lo + 1;
        const int kF = wpar ? 32 : 0, kP = wpar ? 0 : 32, iP = wpar ? 12 : 0;
#pragma unroll
        for (int i = 0; i < 16; ++i) { const int kk = kF + crow32(i, hh_); int ci = kk - qcol + 15; ci = ci < 0 ? 0 : (ci > 30 ? 30 : ci); offF[i] = ((kk >= c0 && kk < c0 + 16) ? ci : 31) * 4; }
#pragma unroll
        for (int i = 0; i < 4; ++i) { const int kk = kP + crow32(iP + i, hh_); int ci = kk - qcol + 15; ci = ci < 0 ? 0 : (ci > 30 ? 30 : ci); offP[i] = ((kk >= c0 && kk < c0 + 16) ? ci : 31) * 4; }
    }
    __device__ __forceinline__ const unsigned short* qptr(int) const { return PJ + (size_t)(b * S + qrow * 64 + qcol) * ODD_IN + h * 64; }
    __device__ __forceinline__ int ntiles() const { return nt_; }
    __device__ __forceinline__ AtTile tile(int j) const { return AtTile{PJ + 512 + h * 64, PJ + 1024 + h * 64, ODD_IN, b * S + (kr_lo + j) * 64, 1, 0, T - 1}; }
    __device__ __forceinline__ bool active(int j) const { const int kr = kr_lo + j; const int rr = __builtin_amdgcn_readfirstlane(r0); return kr >= rr && kr <= rr + 7; }
    __device__ __forceinline__ void finish(const f32x16 (&O)[2], float L, int, int hh) const {
        const float il = 1.0f / L; const size_t t = (size_t)b * S + qrow * 64 + qcol;
#pragma unroll
        for (int dt = 0; dt < 2; ++dt)
#pragma unroll
            for (int qd = 0; qd < 4; ++qd) { const int d = 32 * dt + 8 * qd + 4 * hh;
                *(unsigned*)((unsigned char*)MIXb + t * D + h * 64 + d) = pk4_fp8(O[dt][4 * qd] * il, O[dt][4 * qd + 1] * il, O[dt][4 * qd + 2] * il, O[dt][4 * qd + 3] * il); }
    }
};

template <int DIL>
struct DilPolB {
    static constexpr bool KSCALE = false, PRE = false, RESIDENT = true; static constexpr int NT = (DIL == 16 ? 4 : 6);
    __device__ __forceinline__ bool pv_live(int, int) const { return true; }
    __device__ __forceinline__ void scores(f32x16 (&Sx)[2], int j, int hh, float& Ls) const {
#pragma unroll
        for (int kh = 0; kh < 2; ++kh)
#pragma unroll
            for (int i = 0; i < 16; ++i) { const float sv = Sx[kh][i]; const float pvv = score(sv, kh * 32 + crow32(i, hh), j); Sx[kh][i] = pvv; Ls += pvv; }
    }
    const unsigned short* PJ; unsigned short* MIXb; float* PO_w; float* PL_w; const float* PO1; const float* PO2; const float* PL1; const float* PL2;
    int b, h, cls, qsub, wqs, ks0, unit_cls0;
    static constexpr int LS = S / DIL;
    __device__ __forceinline__ void init(int unit, const unsigned short* PJ_, unsigned short* MIXb_, float* PO_w_, float* PL_w_, const float* PO1_, const float* PO2_, const float* PL1_, const float* PL2_) {
        PJ = PJ_; MIXb = MIXb_; PO_w = PO_w_; PL_w = PL_w_; PO1 = PO1_; PO2 = PO2_; PL1 = PL1_; PL2 = PL2_;
        b = unit >> 6; h = (unit >> 3) & 7; const int sub = unit & 7; const int w = ltid() >> 6, r = ltid() & 31;
        if (DIL == 1) { cls = 0; unit_cls0 = 0; wqs = sub * 256 + w * 32; ks0 = sub * 256 - 64; }
        else if (DIL == 4) { cls = sub >> 1; unit_cls0 = cls; wqs = (sub & 1) * 256 + w * 32; ks0 = (sub & 1) * 256 - 64; }
        else { unit_cls0 = 2 * sub; cls = 2 * sub + (w >> 2); wqs = 32 * (w & 3); ks0 = 0; }
        qsub = wqs + r;
    }
    __device__ __forceinline__ int qtok() const { return b * S + DIL * qsub + cls; }
    __device__ __forceinline__ const unsigned short* qptr(int) const { return PJ + (size_t)qtok() * ODD_IN + 1536 + h * 64; }
    __device__ __forceinline__ int ntiles() const { return DIL == 16 ? 4 : 6; }
    __device__ __forceinline__ int tcls(int j) const { return DIL == 16 ? unit_cls0 + (j >> 1) : unit_cls0; }
    __device__ __forceinline__ int tks(int j) const { return DIL == 16 ? 64 * (j & 1) : ks0 + 64 * j; }
    __device__ __forceinline__ AtTile tile(int j) const { return AtTile{PJ + 2048 + h * 64, PJ + 2560 + h * 64, ODD_IN, b * S + DIL * tks(j) + tcls(j), DIL, b * S, b * S + S - 1}; }
    __device__ __forceinline__ bool active(int j) const { const int k0 = tks(j); const int wl = __builtin_amdgcn_readfirstlane(wqs), wc = __builtin_amdgcn_readfirstlane(cls);
        return (tcls(j) == wc) && (k0 <= wl + 31 + 64) && (k0 + 63 >= wl - 64) && (k0 + 63 >= 0) && (k0 < LS); }
    __device__ __forceinline__ float score(float s, int kk, int j) const { const int ksub = tks(j) + kk, diff = qsub - ksub, ad = diff < 0 ? -diff : diff;
        const bool valid = (ksub >= 0) && (ksub < LS) && (ad <= 64);
        return valid ? __builtin_amdgcn_exp2f(s * 1.4426950408889634f) : 0.f; }
    __device__ __forceinline__ void finish(const f32x16 (&O)[2], float L, int, int hh) const {
        const size_t th = (size_t)qtok() * 8 + h;
        if (DIL != 16) {
            if (hh == 0) PL_w[th] = L;
#pragma unroll
            for (int dt = 0; dt < 2; ++dt)
#pragma unroll
                for (int qd = 0; qd < 4; ++qd) { const int d = 32 * dt + 8 * qd + 4 * hh;
                    uint2 pw; pw.x = pkbf(O[dt][4 * qd], O[dt][4 * qd + 1]); pw.y = pkbf(O[dt][4 * qd + 2], O[dt][4 * qd + 3]); *(uint2*)((unsigned short*)PO_w + th * 64 + d) = pw; }
        } else {
            const float il = 1.0f / (L + PL1[th] + PL2[th]);
#pragma unroll
            for (int dt = 0; dt < 2; ++dt)
#pragma unroll
                for (int qd = 0; qd < 4; ++qd) { const int d = 32 * dt + 8 * qd + 4 * hh;
                    const uint2 aw = *(const uint2*)((const unsigned short*)PO1 + th * 64 + d), cw = *(const uint2*)((const unsigned short*)PO2 + th * 64 + d);
                    *(unsigned*)((unsigned char*)MIXb + (size_t)qtok() * D + 512 + h * 64 + d) = pk4_fp8((O[dt][4 * qd] + bflo(aw.x) + bflo(cw.x)) * il, (O[dt][4 * qd + 1] + bfhi(aw.x) + bfhi(cw.x)) * il,
                                                                                                                   (O[dt][4 * qd + 2] + bflo(aw.y) + bflo(cw.y)) * il, (O[dt][4 * qd + 3] + bfhi(aw.y) + bfhi(cw.y)) * il); }
        }
    }
};

__device__ __forceinline__ void p0_transpose_item(const float* W, int K, int N, bf16* WT, const float* kscale, LAS float* scr, int item, int lane) {
    const int nblk = N / 32, kb = item / nblk, nb = item % nblk, k0 = 64 * kb, n0 = 32 * nb;
    { float wv[32];
#pragma unroll
      for (int i = 0; i < 32; ++i) { const int kk = 2 * i + (lane >> 5); wv[i] = __builtin_nontemporal_load(W + (size_t)(k0 + kk) * N + n0 + (lane & 31)); }
#pragma unroll
      for (int i = 0; i < 32; ++i) { const int kk = 2 * i + (lane >> 5); float w = wv[i]; if (kscale) w *= kscale[k0 + kk]; scr[kk * 33 + (lane & 31)] = w; } }
    asm volatile("s_waitcnt lgkmcnt(0)" ::: "memory");
    const int c = lane & 7;
#pragma unroll
    for (int j = 0; j < 4; ++j) { const int n = (lane >> 3) + 8 * j; const LAS float* s = scr + (8 * c) * 33 + n;
        v4u o; o.x = pk2(s[0 * 33], s[1 * 33]); o.y = pk2(s[2 * 33], s[3 * 33]); o.z = pk2(s[4 * 33], s[5 * 33]); o.w = pk2(s[6 * 33], s[7 * 33]);
        *(v4u*)(WT + (size_t)(n0 + n) * K + k0 + 8 * c) = o; }
    asm volatile("s_waitcnt lgkmcnt(0)" ::: "memory");
}

__device__ __forceinline__ void p0_transpose_item_f8(const float* W, int K, int N, unsigned char* WT8, LAS float* scr, int item, int lane) {
    const int nblk = N / 32, kb = item / nblk, nb = item % nblk, k0 = 64 * kb, n0 = 32 * nb;
    { float wv[32];
#pragma unroll
      for (int i = 0; i < 32; ++i) { const int kk = 2 * i + (lane >> 5); wv[i] = __builtin_nontemporal_load(W + (size_t)(k0 + kk) * N + n0 + (lane & 31)); }
#pragma unroll
      for (int i = 0; i < 32; ++i) { const int kk = 2 * i + (lane >> 5); scr[kk * 33 + (lane & 31)] = wv[i] * W8_SCALE; } }
    asm volatile("s_waitcnt lgkmcnt(0)" ::: "memory");
    const int c = lane & 7;
#pragma unroll
    for (int j = 0; j < 4; ++j) { const int n = (lane >> 3) + 8 * j; const LAS float* sp = scr + (8 * c) * 33 + n;
        uint2 o; o.x = pk4_fp8(sp[0 * 33], sp[1 * 33], sp[2 * 33], sp[3 * 33]); o.y = pk4_fp8(sp[4 * 33], sp[5 * 33], sp[6 * 33], sp[7 * 33]);
        *(uint2*)(WT8 + (size_t)(n0 + n) * K + k0 + 8 * c) = o; }
    asm volatile("s_waitcnt lgkmcnt(0)" ::: "memory");
}

#define XB_TMO      128
#define XB_XCNT(j)  (256  + 64 * (j))
#define XB_XSUB(j)  (1280 + 64 * (j))
#define XB_XGEN(j)  (2304 + 64 * (j))
#define XB_TOP      3328
#define XB_TOPGEN   3392
#define XCD_BAR_WORDS 3456
#define XB_SPIN_CAP (1u << 18)

__device__ __forceinline__ unsigned xb_ld(unsigned* p)              { return __hip_atomic_load(p, __ATOMIC_RELAXED, __HIP_MEMORY_SCOPE_AGENT); }
__device__ __forceinline__ unsigned xb_add(unsigned* p, unsigned v) { return __hip_atomic_fetch_add(p, v, __ATOMIC_RELAXED, __HIP_MEMORY_SCOPE_AGENT); }
__device__ __forceinline__ unsigned xb_xcc_id() { return (unsigned)__builtin_amdgcn_s_getreg((3 << 11) | 20) & 0xFu; }
#define XB_SPIN(cond, bar) do { unsigned _sp = 0; while (cond) { __builtin_amdgcn_s_sleep(1); \
    if ((++_sp & 255u) == 0u) { if (xb_ld(&(bar)[XB_TMO])) break; if (_sp > XB_SPIN_CAP) { atomicAdd(&(bar)[XB_TMO], 1u); break; } } } } while (0)

struct XcdBarrier {
    unsigned* bar; unsigned x;
    volatile LAS unsigned* st;
};

__device__ __forceinline__ XcdBarrier xcd_barrier_post(unsigned* bar, volatile LAS unsigned* st) {
    XcdBarrier b; b.bar = bar; b.x = xb_xcc_id(); b.st = st;
    if (ltid() == 0) (void)xb_add(&bar[XB_XCNT(b.x)], 1u);
    return b;
}
__device__ __forceinline__ void xcd_barrier_complete(unsigned* bar, unsigned x, unsigned& nloc, unsigned& nx) {
    const unsigned G = gridDim.x * gridDim.y * gridDim.z;
    unsigned sum, cnt, mine, sp = 0u;
    for (;;) {
        sum = 0u; cnt = 0u; mine = 0u;
#pragma unroll
        for (unsigned j = 0; j < 16; ++j) { const unsigned c = xb_ld(&bar[XB_XCNT(j)]); sum += c; cnt += (c > 0u) ? 1u : 0u; mine = (j == x) ? c : mine; }
        if (sum == G) break;
        __builtin_amdgcn_s_sleep(1);
        if ((++sp & 255u) == 0u) { if (xb_ld(&bar[XB_TMO])) break; if (sp > XB_SPIN_CAP) { atomicAdd(&bar[XB_TMO], 1u); break; } }
    }
    nloc = mine > 0u ? mine : 1u; nx = cnt > 0u ? cnt : 1u;
}

__device__ __forceinline__ void xcd_barrier(const XcdBarrier& b) {
    asm volatile("s_waitcnt vmcnt(0)" ::: "memory");
    __syncthreads();
    if (ltid() == 0) {
        unsigned* bar = b.bar;
        __builtin_amdgcn_s_waitcnt(0);
        unsigned nloc = b.st[0], nx = b.st[1];
        if (nloc == 0u) { xcd_barrier_complete(bar, b.x, nloc, nx); b.st[0] = nloc; b.st[1] = nx; }
        const unsigned old = xb_add(&bar[XB_XSUB(b.x)], 1u);
        const unsigned gen = old / nloc;
        asm volatile("buffer_inv sc1" ::: "memory");
        if (old + 1u == (gen + 1u) * nloc) {
            __builtin_amdgcn_fence(__ATOMIC_RELEASE, "agent");
            asm volatile("s_waitcnt vmcnt(0)" ::: "memory");
            const unsigned og = xb_add(&bar[XB_TOP], 1u);
            const unsigned tg = og / nx;
            if (og + 1u == (tg + 1u) * nx) xb_add(&bar[XB_TOPGEN], 1u);
            else XB_SPIN(xb_ld(&bar[XB_TOPGEN]) == tg, bar);
            xb_add(&bar[XB_XGEN(b.x)], 1u);
            asm volatile("s_waitcnt vmcnt(0)" ::: "memory");
        } else {
            XB_SPIN(xb_ld(&bar[XB_XGEN(b.x)]) == gen, bar);
            asm volatile("s_waitcnt vmcnt(0)" ::: "memory");
        }
    }
    __syncthreads();
}

struct Params {
    const float* in[27];
    float* out; char* ws;
};

#define LOOPVB(nvb, call) do { int tid = ltid() & 255, half = ltid() >> 8; asm volatile("" : "+v"(tid), "+v"(half)); float* smem = (float*)(lds + half * 16384); (void)smem; for (int vb = blockIdx.x * 2 + half; vb < (nvb); vb += gridDim.x * 2) { call; } } while (0)
#define PHASE(nvb, call) do { LOOPVB(nvb, call); xcd_barrier(bar); } while (0)
#define GEMMP(A_, B_, N_, C_, R_) do { pg8::Gemm g{A_, B_, T, N_, D}; pg8::StaticOrder So; So.init(T, N_, (int)gridDim.x, (int)blockIdx.x); pg8::EpiF32R E{C_, N_, R_}; \
        pg8::gemm_phase<pg8::EpiF32R, pg8::StaticOrder, true, true>((PG8_LAS unsigned char*)lds, g, So, E); xcd_barrier(bar); } while (0)

#define GEMMB(A_, B_, N_, O_) do { pg8::Gemm g{A_, B_, T, N_, D}; pg8::StaticOrder So; So.init(T, N_, (int)gridDim.x, (int)blockIdx.x); pg8::EpiBf16<0> E{O_, N_, nullptr, 0, 0, 1.f}; \
        pg8::gemm_phase<pg8::EpiBf16<0>, pg8::StaticOrder, true, true>((PG8_LAS unsigned char*)lds, g, So, E); xcd_barrier(bar); } while (0)

#define UMAP(u_) ((gridDim.x == 256) ? ((((u_) & 7) * 8 + ((u_) >> 8) * 4 + (((u_) >> 6) & 3)) * 8 + (((u_) >> 3) & 7)) : (u_))
__global__ void __launch_bounds__(512, 2) fwd_megakernel(Params p) {
    extern __shared__ __attribute__((aligned(16))) unsigned char lds[];
    { volatile LAS unsigned* st0 = (volatile LAS unsigned*)((LAS unsigned char*)lds + 147456 - 64); if (ltid() < 16) st0[ltid()] = 0u; }
    __syncthreads();
    const XcdBarrier bar = xcd_barrier_post((unsigned*)p.ws, (volatile LAS unsigned*)((LAS unsigned char*)lds + 147456 - 64));
    const float* x = p.in[0]; const float* mix_gain = p.in[1]; const float* ffn_gain = p.in[2]; const float* ev_w_in = p.in[3]; const float* ev_w_out = p.in[4];
    const float* hy_conv_w = p.in[5]; const float* hy_conv_b = p.in[6]; const float* fw1 = p.in[7]; const float* fb1 = p.in[8]; const float* fw2 = p.in[9];
    const float* fb2 = p.in[10]; const float* fw3 = p.in[11]; const float* fb3 = p.in[12]; const float* fw_out = p.in[13]; const float* hy_freq = p.in[14];
    const float* hy_skip = p.in[15]; const float* ret_log_decay = p.in[16]; const float* ret_gn_gain = p.in[17]; const float* od_w_in = p.in[18]; const float* od_w_out = p.in[19];
    const float* na_qk_gain = p.in[20]; const float* na_rpb = p.in[21]; const float* dil_qk_gain = p.in[22]; const float* peer_w_q = p.in[23]; const float* peer_sub_keys = p.in[24];
    const float* peer_u = p.in[25]; const float* peer_v = p.in[26];
    float* XS = p.out;
    char* ws = p.ws; size_t off = 65536;
    auto carve = [&](size_t bytes) { char* q = ws + off; off += (bytes + 255) & ~(size_t)255; return q; };
    float* Z = (float*)carve((size_t)T * 512 * 4);
    float* RSS0 = (float*)carve((size_t)T * 16 * 4); float* RSS1 = (float*)carve((size_t)T * 16 * 4);
    bf16* PROJ = (bf16*)carve((size_t)T * EVEN_IN * 2);
    float* UC = (float*)carve((size_t)T * HY_IN * 4);
    float* MIX = (float*)carve((size_t)T * D * 4);
    float* FILT = (float*)carve((size_t)2 * 2 * S * HYC * 4);
    bf16* EXP = (bf16*)carve((size_t)T * 128 * 2);
    float* GATE = (float*)carve((size_t)T * 128 * 4);
    bf16* SKB = (bf16*)carve((size_t)2 * 8 * 2 * 128 * 64 * 2);
    float2* CS = (float2*)carve((size_t)S * 32 * 8);
    unsigned char* UB = (unsigned char*)carve((size_t)2 * 16384 * D);
    unsigned char* VB = (unsigned char*)carve((size_t)2 * 16384 * D);
    bf16* WT_in0 = (bf16*)carve((size_t)EVEN_IN * D * 2);
    bf16* WT_out0 = (bf16*)carve((size_t)D * D * 2);
    bf16* WT_in1 = (bf16*)carve((size_t)ODD_IN * D * 2);
    bf16* WT_out1 = (bf16*)carve((size_t)D * D * 2);
    bf16* WT_q0 = (bf16*)carve((size_t)D * D * 2);
    bf16* WT_q1 = (bf16*)carve((size_t)D * D * 2);
    bf16* Ab = (bf16*)UC;
    bf16* Qb = Ab + (size_t)T * D;
    bf16* XB = Qb + (size_t)T * D;

#define WV_SETUP const int lane = ltid() & 63; const int wave = __builtin_amdgcn_readfirstlane(ltid() >> 6); const int gw = blockIdx.x * 8 + wave, NGW = gridDim.x * 8; \
    LAS float* wscr = (LAS float*)((LAS unsigned char*)lds + wave * 16384); (void)lane; (void)gw; (void)NGW; (void)wscr;

    bf16* GFf = (bf16*)FILT; bf16* GFb = GFf + (size_t)2 * HYC * S;
    bf16* HYT = PROJ; bf16* RET = PROJ + (size_t)HY_IN * T;
    {
        WV_SETUP
        if (wave < P0_NFW) {
            for (int it = blockIdx.x; it < S / 8; it += gridDim.x) hy_filters_wave(it, wave, lane, wscr, fw1, fb1, fw2, fb2, fw3, fb3, fw_out, hy_freq, GFf, GFb);
            const size_t g0 = (size_t)(blockIdx.x * P0_NFW + wave) * 64 + lane, G0 = (size_t)gridDim.x * (P0_NFW * 64);
            for (size_t i = g0; i < (size_t)S * 32; i += G0) { const int pos = (int)(i >> 5), fi = (int)(i & 31);
                const float inv = powf(10000.0f, -(float)(2 * fi) / 64.0f); const float ang = (float)pos * inv; CS[i] = make_float2(cosf(ang), sinf(ang)); }
            for (size_t i = g0; i < (size_t)2 * 8 * 2 * 128 * 64 / 8; i += G0) {
                const float4 a = ((const float4*)peer_sub_keys)[2 * i], b = ((const float4*)peer_sub_keys)[2 * i + 1]; v4u w; w.x = pk2(a.x, a.y); w.y = pk2(a.z, a.w); w.z = pk2(b.x, b.y); w.w = pk2(b.z, b.w); ((v4u*)SKB)[i] = w; }
        } else {
            const int gw7 = blockIdx.x * (8 - P0_NFW) + (wave - P0_NFW), NGW7 = gridDim.x * (8 - P0_NFW);
            for (int r0 = gw7 * 2; r0 < T; r0 += NGW7 * 2) {
                float4 v[2][4]; float ss[2];
#pragma unroll
                for (int q = 0; q < 2; ++q)
#pragma unroll
                    for (int j = 0; j < 4; ++j) { typedef float f4nt __attribute__((ext_vector_type(4))); const f4nt t4 = __builtin_nontemporal_load((const f4nt*)(x + (size_t)(r0 + q) * D) + lane + 64 * j); v[q][j] = make_float4(t4.x, t4.y, t4.z, t4.w); }
#pragma unroll
                for (int q = 0; q < 2; ++q) { float s = 0.f;
#pragma unroll
                    for (int j = 0; j < 4; ++j) s += (v[q][j].x * v[q][j].x + v[q][j].y * v[q][j].y) + (v[q][j].z * v[q][j].z + v[q][j].w * v[q][j].w);
                    ss[q] = 1.0f / sqrtf(wave_sum(s) * (1.0f / D) + EPS); }
#pragma unroll
                for (int j = 0; j < 4; ++j) { const float4 g = ((const float4*)mix_gain)[lane + 64 * j];
#pragma unroll
                    for (int q = 0; q < 2; ++q) { uint2 w; w.x = pkbf(v[q][j].x * ss[q] * g.x, v[q][j].y * ss[q] * g.y); w.y = pkbf(v[q][j].z * ss[q] * g.z, v[q][j].w * ss[q] * g.w);
                        ((uint2*)(Ab + (size_t)(r0 + q) * D))[lane + 64 * j] = w; } }
            }
            constexpr int I_IN0 = (D / 64) * (EVEN_IN / 32), I_SQ = (D / 64) * (D / 32), I_IN1 = (D / 64) * (ODD_IN / 32);
            constexpr int NITEMS = I_IN0 + I_IN1 + 4 * I_SQ;
            for (int it = gw7; it < NITEMS; it += NGW7) {
                int r = it;
                if (r < I_IN0) { p0_transpose_item(ev_w_in, D, EVEN_IN, WT_in0, nullptr, wscr, r, lane); continue; } r -= I_IN0;
                if (r < I_IN1) { p0_transpose_item_f8(od_w_in, D, ODD_IN, (unsigned char*)WT_in1, wscr, r, lane); continue; } r -= I_IN1;
                if (r < I_SQ) { p0_transpose_item(ev_w_out, D, D, WT_out0, nullptr, wscr, r, lane); continue; } r -= I_SQ;
                if (r < I_SQ) { p0_transpose_item_f8(od_w_out, D, D, (unsigned char*)WT_out1, wscr, r, lane); continue; } r -= I_SQ;
                if (r < I_SQ) { p0_transpose_item(peer_w_q, D, D, WT_q0, ffn_gain, wscr, r, lane); continue; } r -= I_SQ;
                p0_transpose_item(peer_w_q + (size_t)D * D, D, D, WT_q1, ffn_gain + D, wscr, r, lane);
            }
            const size_t gt = (size_t)gw7 * 64 + lane, GT = (size_t)NGW7 * 64;
#pragma unroll 8
            for (size_t pidx = gt; pidx < (size_t)16384 * D / 8; pidx += GT) {
                typedef float f4nt __attribute__((ext_vector_type(4)));
                const f4nt a0v = __builtin_nontemporal_load((const f4nt*)peer_u + 2 * pidx), a1v = __builtin_nontemporal_load((const f4nt*)peer_u + 2 * pidx + 1);
                float4 a0 = make_float4(a0v.x, a0v.y, a0v.z, a0v.w), a1 = make_float4(a1v.x, a1v.y, a1v.z, a1v.w);
                const float4* gq = (const float4*)(ffn_gain + (pidx >= (size_t)16384 * D / 8 ? D : 0) + (size_t)((pidx * 8) & (D - 1))); const float4 g0 = gq[0], g1 = gq[1];
                a0.x *= g0.x; a0.y *= g0.y; a0.z *= g0.z; a0.w *= g0.w; a1.x *= g1.x; a1.y *= g1.y; a1.z *= g1.z; a1.w *= g1.w;
                ((unsigned*)UB)[pidx] = pk8_fp4(a0, a1, U8_SCALE);
                const f4nt c0v = __builtin_nontemporal_load((const f4nt*)peer_v + 2 * pidx), c1v = __builtin_nontemporal_load((const f4nt*)peer_v + 2 * pidx + 1);
                const float4 c0 = make_float4(c0v.x, c0v.y, c0v.z, c0v.w), c1 = make_float4(c1v.x, c1v.y, c1v.z, c1v.w);
                ((unsigned*)VB)[pidx] = pk8_fp4(c0, c1, V8_SCALE);
            }
        }
    }
    xcd_barrier(bar);
    {
        pg8::Gemm g{WT_in0, Ab, HY_IN, T, D}; pg8::StaticOrder So; So.init(HY_IN, T, (int)gridDim.x, (int)blockIdx.x); pg8::EpiBf16<0> E{HYT, T, nullptr, 0, 0, 1.f};
        pg8::gemm_phase<pg8::EpiBf16<0>, pg8::StaticOrder, true, true>((PG8_LAS unsigned char*)lds, g, So, E);
    }
    if (gridDim.x == 256) {
        pg8::Gemm g{Ab, WT_in0 + (size_t)HY_IN * D, T, 2048, D}; const RetOrder So{(int)blockIdx.x}; pg8::EpiHead<0> E{RET, 2048, nullptr, nullptr, (const float*)CS, S - 1, EPS, 1.0f};
        pg8::gemm_phase<pg8::EpiHead<0>, RetOrder, true, true>((PG8_LAS unsigned char*)lds, g, So, E);
        if (blockIdx.x >= 128) {
            asm volatile("s_waitcnt vmcnt(0)" ::: "memory");
            __syncthreads();
            const int k = ((int)blockIdx.x & 127) >> 3, pm = ((int)blockIdx.x & 7) * 8 + (k >> 1), b = pm >> 3, c = pm & 7, h0 = 4 * (k & 1);
#pragma unroll 1
            for (int hi = 0; hi < 4; ++hi) ret_kv_unit(b * 64 + (h0 + hi) * 8 + c, RET, ret_log_decay, Z, (LAS unsigned char*)lds);
        }
        xcd_barrier(bar);
    } else {
        {
            pg8::Gemm g{Ab, WT_in0 + (size_t)HY_IN * D, T, 2048, D}; pg8::StaticOrder So; So.init(T, 2048, (int)gridDim.x, (int)blockIdx.x); pg8::EpiHead<0> E{RET, 2048, nullptr, nullptr, (const float*)CS, S - 1, EPS, 1.0f};
            pg8::gemm_phase<pg8::EpiHead<0>, pg8::StaticOrder, true, true>((PG8_LAS unsigned char*)lds, g, So, E);
        }
        xcd_barrier(bar);
        for (int u = blockIdx.x; u < NB * 8 * 8; u += gridDim.x) ret_kv_unit(UMAP(u), RET, ret_log_decay, Z, (LAS unsigned char*)lds);
        xcd_barrier(bar);
    }
    for (int u = blockIdx.x; u < HYC / 2; u += gridDim.x) { const int cp = (gridDim.x == 256) ? ((u & 7) * 32 + (u >> 3)) : u;
        TabJob jb{peer_u, peer_v, ffn_gain + D, (unsigned*)UB, (unsigned*)VB, (size_t)16384 * D / 8 + (size_t)blockIdx.x * 512, (size_t)gridDim.x * 512, (size_t)2 * 16384 * D / 8, (u == (int)blockIdx.x) ? HY_TABCNT : 0};
        hy_unit(cp, (LAS unsigned char*)lds, HYT, GFf, GFb, hy_conv_w, hy_conv_b, hy_skip, Ab, jb); }
    {
        const int jdone = ((int)blockIdx.x < HYC / 2) ? 2 * HY_TABCNT : 0;
        TabJob jb{peer_u, peer_v, ffn_gain + D, (unsigned*)UB, (unsigned*)VB, (size_t)16384 * D / 8 + (size_t)blockIdx.x * 512 + ltid(), (size_t)gridDim.x * 512, (size_t)2 * 16384 * D / 8, 0};
        const float4* gq = (const float4*)(jb.gain + (size_t)((jb.first * 8) & (D - 1))); const float4 g0 = gq[0], g1 = gq[1];
        for (int j = jdone; jb.first + (size_t)j * jb.stride < jb.end; ++j) { f4nt_t X[4]; tab_issue(jb, j, X); tab_convert(jb, j, X, g0, g1); }
    }
    for (int u = blockIdx.x; u < NB * 8 * 8; u += gridDim.x) { RetPol P; P.init(UMAP(u), RET, ret_log_decay, ret_gn_gain, Ab, Z); attn_unit(P, (LAS unsigned char*)lds); }
    xcd_barrier(bar);
    { pg8::Gemm g{Ab, WT_out0, T, D, D}; pg8::StaticOrder So; So.init(T, D, (int)gridDim.x, (int)blockIdx.x); pg8::EpiResXB<false> E{x, D, XB, RSS0, 1.0f};
      pg8::gemm_phase<pg8::EpiResXB<false>, pg8::StaticOrder, true, true>((PG8_LAS unsigned char*)lds, g, So, E); xcd_barrier(bar); }
    { pg8::Gemm g{XB, WT_q0, T, D, D}; pg8::StaticOrder So; So.init(T, D, (int)gridDim.x, (int)blockIdx.x); EpiQSel E{RSS0, 1.0f / D, EPS, SKB, EXP, GATE}; pg8::Unit uu;
      for (int i = 0; So.next(i, uu); ++i) { const OneUnit Su{uu}; pg8::gemm_phase<EpiQSel, OneUnit, true, true>((PG8_LAS unsigned char*)lds, g, Su, E); }
      xcd_barrier(bar); }
    { WV_SETUP
    for (int t = gw; t < T; t += NGW) peer_gather_token(XB, RSS0, UB, VB, EXP, GATE, XS, mix_gain + D, Ab, t, lane, wscr); }
    xcd_barrier(bar);
    { pg8::Gemm g{Ab, WT_in1, T, ODD_IN, D}; pg8::StaticOrder So; So.init(T, ODD_IN, (int)gridDim.x, (int)blockIdx.x); pg8::EpiHead<1> E{PROJ, ODD_IN, na_qk_gain, dil_qk_gain, (const float*)CS, S - 1, EPS, 1.0f / W8_SCALE};
      pg8::gemm_phase<pg8::EpiHead<1>, pg8::StaticOrder, true, false, true>((PG8_LAS unsigned char*)lds, g, So, E); xcd_barrier(bar); }
    for (int u = blockIdx.x; u < NB * 8 * 8; u += gridDim.x) {
        LAS float* tab = (LAS float*)((LAS unsigned char*)lds + AT_TAB_OFF);
        const int um = UMAP(u);
        __syncthreads();
        if (ltid() < 15 * 32) { const int tr_ = ltid() >> 5, tc_ = ltid() & 31; tab[ltid()] = tc_ < 31 ? na_rpb[((um >> 3) & 7) * (15 * 31) + tr_ * 31 + tc_] * 1.4426950408889634f : -__builtin_inff(); }
        NaPol P; P.init(um, PROJ, Ab, tab); attn_unit(P, (LAS unsigned char*)lds);
    }
    {
        float* PO1 = MIX; float* PO2 = MIX + (size_t)T * 512; float* PL1 = Z; float* PL2 = Z + (size_t)T * 8;
        for (int u = blockIdx.x; u < NB * 8 * 8; u += gridDim.x) { DilPolB<1> P; P.init(UMAP(u), PROJ, Ab, PO1, PL1, nullptr, nullptr, nullptr, nullptr); attn_unit(P, (LAS unsigned char*)lds); }
        for (int u = blockIdx.x; u < NB * 8 * 8; u += gridDim.x) { DilPolB<4> P; P.init(UMAP(u), PROJ, Ab, PO2, PL2, nullptr, nullptr, nullptr, nullptr); attn_unit(P, (LAS unsigned char*)lds); }
        xcd_barrier(bar);
        for (int u = blockIdx.x; u < NB * 8 * 8; u += gridDim.x) { DilPolB<16> P; P.init(UMAP(u), PROJ, Ab, nullptr, nullptr, PO1, PO2, PL1, PL2); attn_unit(P, (LAS unsigned char*)lds); }
    }
    xcd_barrier(bar);
    { pg8::Gemm g{Ab, WT_out1, T, D, D}; pg8::StaticOrder So; So.init(T, D, (int)gridDim.x, (int)blockIdx.x); pg8::EpiResXB<true> E{XB, D, XB, RSS1, 1.0f / W8_SCALE};
      pg8::gemm_phase<pg8::EpiResXB<true>, pg8::StaticOrder, true, false, true>((PG8_LAS unsigned char*)lds, g, So, E); xcd_barrier(bar); }
    { pg8::Gemm g{XB, WT_q1, T, D, D}; pg8::StaticOrder So; So.init(T, D, (int)gridDim.x, (int)blockIdx.x); EpiQSel E{RSS1, 1.0f / D, EPS, SKB + (size_t)8 * 2 * 128 * 64, EXP, GATE}; pg8::Unit uu;
      for (int i = 0; So.next(i, uu); ++i) { const OneUnit Su{uu}; pg8::gemm_phase<EpiQSel, OneUnit, true, true>((PG8_LAS unsigned char*)lds, g, Su, E); }
      xcd_barrier(bar); }
    { WV_SETUP
    for (int t = gw; t < T; t += NGW) peer_gather_token(XB, RSS1, UB + (size_t)16384 * (D / 2), VB + (size_t)16384 * (D / 2), EXP, GATE, XS, nullptr, nullptr, t, lane, wscr); }
}
}

extern "C" void kernel_launch(void* const* d_in, const int* in_sizes, int n_in, void* d_out, int out_size, void* d_ws, size_t ws_size, hipStream_t stream) {
    static int grid_blocks = 0;
    if (!grid_blocks) {
        int dev = 0, cus = 0;
        (void)hipGetDevice(&dev);
        (void)hipDeviceGetAttribute(&cus, hipDeviceAttributeMultiprocessorCount, dev);
        (void)hipFuncSetAttribute((const void*)fwd_megakernel, hipFuncAttributeMaxDynamicSharedMemorySize, LDS_BYTES);
        int per_cu = 0;
        if (hipOccupancyMaxActiveBlocksPerMultiprocessor(&per_cu, (const void*)fwd_megakernel, 512, (size_t)LDS_BYTES) != hipSuccess) per_cu = 1;
        (void)per_cu;
        grid_blocks = cus;
    }
    Params p{};
    for (int i = 0; i < 27; ++i) p.in[i] = (const float*)d_in[i];
    p.out = (float*)d_out; p.ws = (char*)d_ws;
    (void)hipMemsetAsync(d_ws, 0, 65536, stream);
    hipLaunchKernelGGL(fwd_megakernel, dim3(grid_blocks), dim3(512), LDS_BYTES, stream, p);
}
```
